# Optimizing an MI355X kernel written in HIP

```python
import jax, jax.numpy as jnp
from jax import lax
import numpy as np

D_MODEL = 1024
BATCH = 8
SEQ = 4096
DEPTH = 2

CTX_LEN = 256
GRID_W = 64
EPS = 1e-6
N_MOD = 9
D_FF = 2816

FNET_GROUPS = 4
FNET_GROUP_DIM = 128
FNET_DIM = FNET_GROUPS * FNET_GROUP_DIM
NA_HEADS = 8
NA_HEAD_DIM = 64
NA_DIM = NA_HEADS * NA_HEAD_DIM
NA_KH = 8
NA_KW = 16
AB_IN_DIM = FNET_DIM + 3 * NA_DIM
AB_OUT_DIM = FNET_DIM + NA_DIM
MLA_HEADS = 8
MLA_NOPE = 128
MLA_ROPE = 64
MLA_V = 128
MLA_Q_RANK = 384
MLA_KV_RANK = 128
MLA_IN_DIM = MLA_Q_RANK + MLA_KV_RANK + MLA_ROPE
ROPE_BASE = 10000.0
Q_BLOCK = 128

N_EVEN = (DEPTH + 1) // 2
N_ODD = DEPTH // 2

kernel_name = "hybrid_fnet_natten_mla_macaron_dit"


def rmsnorm(x, g):
    xf = x.astype(jnp.float32)
    y = xf * lax.rsqrt(jnp.mean(xf * xf, axis=-1, keepdims=True) + EPS)
    return (y * g.astype(jnp.float32)).astype(x.dtype)


def swiglu(h, w_gate, w_up, w_down):
    return (jax.nn.silu(h @ w_gate) * (h @ w_up)) @ w_down


def half_ffn(x, shift, scale, gate, g, w_gate, w_up, w_down):
    h = rmsnorm(x, g) * (1 + scale) + shift
    return x + 0.5 * gate * swiglu(h, w_gate, w_up, w_down)


def axial_rope_tables(n_tok, rot_dim):
    pos = jnp.arange(n_tok)
    row = (pos // GRID_W).astype(jnp.float32)
    col = (pos % GRID_W).astype(jnp.float32)
    half = rot_dim // 2
    inv = ROPE_BASE ** (-jnp.arange(0, half, 2, dtype=jnp.float32) / half)
    ang_r = row[:, None] * inv[None]
    ang_c = col[:, None] * inv[None]
    ang = jnp.concatenate([ang_r, ang_r, ang_c, ang_c], axis=-1)
    return jnp.cos(ang), jnp.sin(ang)


def apply_axial_rope(x, cos, sin):
    xf = x.astype(jnp.float32)
    a, b, cc, d = jnp.split(xf, 4, axis=-1)
    rot = jnp.concatenate([-b, a, -d, cc], axis=-1)
    return (xf * cos + rot * sin).astype(x.dtype)


def fourier_mix(u):
    b, n, _ = u.shape
    ug = u.astype(jnp.float32).reshape(b, n, FNET_GROUPS, FNET_GROUP_DIM)
    f = jnp.fft.fft2(ug, axes=(1, 3), norm="ortho").real
    return f.reshape(b, n, FNET_DIM).astype(u.dtype)


def dense_attention(q, k, v):
    s = jnp.einsum('bqhd,bkhd->bhqk', q, k, preferred_element_type=jnp.float32) * (q.shape[-1] ** -0.5)
    p = jax.nn.softmax(s, axis=-1).astype(v.dtype)
    return jnp.einsum('bhqk,bkhd->bqhd', p, v)


def neighbourhood_attention(q, k, v, k_ctx, v_ctx, rpb):
    b, s, h, dh = q.shape
    rows = s // GRID_W
    kh = min(NA_KH, rows)
    kw = NA_KW
    scale = dh ** -0.5
    qg = q.reshape(b, rows, GRID_W, h, dh)
    kg = k.reshape(b, rows, GRID_W, h, dh)
    vg = v.reshape(b, rows, GRID_W, h, dh)
    cols = jnp.arange(GRID_W)
    col_start = jnp.clip(cols - kw // 2, 0, GRID_W - kw)
    col_idx = col_start[:, None] + jnp.arange(kw)[None, :]
    col_off = col_idx - cols[:, None] + (NA_KW - 1)

    def one_row(r):
        r0 = jnp.clip(r - kh // 2, 0, rows - kh)
        row_off = r0 + jnp.arange(kh) - r + (NA_KH - 1)
        k_band = lax.dynamic_slice_in_dim(kg, r0, kh, axis=1)
        v_band = lax.dynamic_slice_in_dim(vg, r0, kh, axis=1)
        k_win = k_band[:, :, col_idx]
        v_win = v_band[:, :, col_idx]
        qr = lax.dynamic_index_in_dim(qg, r, axis=1, keepdims=False)
        bias = rpb[:, row_off[:, None, None], col_off[None, :, :]]
        bias = jnp.transpose(bias, (0, 2, 1, 3)).reshape(h, GRID_W, kh * kw).astype(jnp.float32)
        s_win = jnp.einsum('bqhd,biqjhd->bhqij', qr, k_win, preferred_element_type=jnp.float32)
        s_win = s_win.reshape(b, h, GRID_W, kh * kw) * scale + bias[None]
        s_ctx = jnp.einsum('bqhd,blhd->bhql', qr, k_ctx, preferred_element_type=jnp.float32) * scale
        p = jax.nn.softmax(jnp.concatenate([s_win, s_ctx], axis=-1), axis=-1).astype(v.dtype)
        p_win = p[..., :kh * kw].reshape(b, h, GRID_W, kh, kw)
        p_ctx = p[..., kh * kw:]
        return (jnp.einsum('bhqij,biqjhd->bqhd', p_win, v_win)
                + jnp.einsum('bhql,blhd->bqhd', p_ctx, v_ctx))

    o = lax.map(one_row, jnp.arange(rows))
    return jnp.transpose(o, (1, 0, 2, 3, 4)).reshape(b, s, h * dh)


def fourier_na_mixer(h_lat, h_ctx, w_in, rpb, w_out, need_ctx_out):
    def split(z):
        u = z[..., :FNET_DIM]
        qkv = z[..., FNET_DIM:].reshape(z.shape[0], z.shape[1], 3, NA_HEADS, NA_HEAD_DIM)
        return u, qkv[:, :, 0], qkv[:, :, 1], qkv[:, :, 2]

    u_l, q_l, k_l, v_l = split(h_lat @ w_in)
    u_c, q_c, k_c, v_c = split(h_ctx @ w_in)
    a_l = fourier_mix(u_l)
    b_l = neighbourhood_attention(q_l, k_l, v_l, k_c, v_c, rpb)
    y_lat = jnp.concatenate([a_l, b_l], axis=-1) @ w_out
    if not need_ctx_out:
        return y_lat, None
    a_c = fourier_mix(u_c)
    b_c = dense_attention(q_c, k_c, v_c).reshape(h_ctx.shape[0], h_ctx.shape[1], NA_DIM)
    y_ctx = jnp.concatenate([a_c, b_c], axis=-1) @ w_out
    return y_lat, y_ctx


def mla_block_attention(q_nope, q_rope, k_nope, k_rope, v):
    b, n, h, _ = q_nope.shape
    nb = n // Q_BLOCK
    scale = (MLA_NOPE + MLA_ROPE) ** -0.5
    qn = q_nope.reshape(b, nb, Q_BLOCK, h, MLA_NOPE).swapaxes(0, 1)
    qr = q_rope.reshape(b, nb, Q_BLOCK, h, MLA_ROPE).swapaxes(0, 1)

    def one_block(args):
        qn_b, qr_b = args
        s = (jnp.einsum('bqhd,bkhd->bhqk', qn_b, k_nope, preferred_element_type=jnp.float32)
             + jnp.einsum('bqhr,bkr->bhqk', qr_b, k_rope, preferred_element_type=jnp.float32)) * scale
        p = jax.nn.softmax(s, axis=-1).astype(v.dtype)
        return jnp.einsum('bhqk,bkhd->bqhd', p, v)

    o = lax.map(one_block, (qn, qr))
    return o.swapaxes(0, 1).reshape(b, n, h * MLA_V)


def mla_mixer(h_lat, h_ctx, w_in, g_q, g_kv, w_uq, w_uk, w_uv, w_o, cos, sin, need_ctx_out):
    def project(hh):
        bb, nn = hh.shape[0], hh.shape[1]
        z = hh @ w_in
        c_q = rmsnorm(z[..., :MLA_Q_RANK], g_q)
        c_kv = rmsnorm(z[..., MLA_Q_RANK:MLA_Q_RANK + MLA_KV_RANK], g_kv)
        k_rope = z[..., MLA_Q_RANK + MLA_KV_RANK:]
        q = (c_q @ w_uq).reshape(bb, nn, MLA_HEADS, MLA_NOPE + MLA_ROPE)
        k_nope = (c_kv @ w_uk).reshape(bb, nn, MLA_HEADS, MLA_NOPE)
        v = (c_kv @ w_uv).reshape(bb, nn, MLA_HEADS, MLA_V)
        return q[..., :MLA_NOPE], q[..., MLA_NOPE:], k_nope, k_rope, v

    qn_l, qr_l, kn_l, kr_l, v_l = project(h_lat)
    qn_c, qr_c, kn_c, kr_c, v_c = project(h_ctx)
    qr_l = apply_axial_rope(qr_l, cos[:, None, :], sin[:, None, :])
    kr_l = apply_axial_rope(kr_l, cos, sin)
    kn_all = jnp.concatenate([kn_l, kn_c], axis=1)
    kr_all = jnp.concatenate([kr_l, kr_c], axis=1)
    v_all = jnp.concatenate([v_l, v_c], axis=1)
    y_lat = mla_block_attention(qn_l, qr_l, kn_all, kr_all, v_all) @ w_o
    if not need_ctx_out:
        return y_lat, None
    y_ctx = mla_block_attention(qn_c, qr_c, kn_c, kr_c, v_c) @ w_o
    return y_lat, y_ctx


def setup_inputs(seed: int = 0) -> dict:
    key = jax.random.key(seed)
    ks = jax.random.split(key, 24)
    f32 = jnp.float32

    def nrm(k, shape, std):
        return jax.random.normal(k, shape, f32) * std

    return {
        "x": nrm(ks[0], (BATCH, SEQ, D_MODEL), 1.0),
        "c": nrm(ks[1], (BATCH, D_MODEL), 1.0),
        "ctx": nrm(ks[2], (BATCH, CTX_LEN, D_MODEL), 1.0),
        "c_ctx": nrm(ks[3], (D_MODEL,), 1.0),
        "ada_w": nrm(ks[4], (DEPTH, D_MODEL, N_MOD * D_MODEL), 0.5 * D_MODEL ** -0.5),
        "ada_b": nrm(ks[5], (DEPTH, N_MOD * D_MODEL), 0.02),
        "norm_g": 1.0 + nrm(ks[6], (DEPTH, 3, D_MODEL), 0.02),
        "ffn_w_gate": nrm(ks[7], (DEPTH, 2, D_MODEL, D_FF), D_MODEL ** -0.5),
        "ffn_w_up": nrm(ks[8], (DEPTH, 2, D_MODEL, D_FF), D_MODEL ** -0.5),
        "ffn_w_down": nrm(ks[9], (DEPTH, 2, D_FF, D_MODEL), D_FF ** -0.5),
        "ab_w_in": nrm(ks[10], (N_EVEN, D_MODEL, AB_IN_DIM), D_MODEL ** -0.5),
        "ab_rpb": nrm(ks[11], (N_EVEN, NA_HEADS, 2 * NA_KH - 1, 2 * NA_KW - 1), 0.1),
        "ab_w_out": nrm(ks[12], (N_EVEN, AB_OUT_DIM, D_MODEL), AB_OUT_DIM ** -0.5),
        "mla_w_in": nrm(ks[13], (N_ODD, D_MODEL, MLA_IN_DIM), D_MODEL ** -0.5),
        "mla_g_q": 1.0 + nrm(ks[14], (N_ODD, MLA_Q_RANK), 0.02),
        "mla_g_kv": 1.0 + nrm(ks[15], (N_ODD, MLA_KV_RANK), 0.02),
        "mla_w_uq": nrm(ks[16], (N_ODD, MLA_Q_RANK, MLA_HEADS * (MLA_NOPE + MLA_ROPE)), MLA_Q_RANK ** -0.5),
        "mla_w_uk": nrm(ks[17], (N_ODD, MLA_KV_RANK, MLA_HEADS * MLA_NOPE), MLA_KV_RANK ** -0.5),
        "mla_w_uv": nrm(ks[18], (N_ODD, MLA_KV_RANK, MLA_HEADS * MLA_V), MLA_KV_RANK ** -0.5),
        "mla_w_o": nrm(ks[19], (N_ODD, MLA_HEADS * MLA_V, D_MODEL), (MLA_HEADS * MLA_V) ** -0.5),
        "final_g": 1.0 + nrm(ks[20], (D_MODEL,), 0.02),
    }


def reference(x, c, ctx, c_ctx, ada_w, ada_b, norm_g, ffn_w_gate, ffn_w_up, ffn_w_down,
              ab_w_in, ab_rpb, ab_w_out, mla_w_in, mla_g_q, mla_g_kv, mla_w_uq, mla_w_uk,
              mla_w_uv, mla_w_o, final_g):
    n_lat = x.shape[1]
    cos, sin = axial_rope_tables(n_lat, MLA_ROPE)
    sc = jax.nn.silu(c)
    scc = jax.nn.silu(c_ctx)
    x_l, x_c = x, ctx
    for layer in range(DEPTH):
        last = layer == DEPTH - 1
        mod_l = (sc @ ada_w[layer] + ada_b[layer]).reshape(-1, N_MOD, D_MODEL)[:, :, None, :]
        mod_c = (scc @ ada_w[layer] + ada_b[layer]).reshape(N_MOD, D_MODEL)

        x_l = half_ffn(x_l, mod_l[:, 0], mod_l[:, 1], mod_l[:, 2], norm_g[layer, 0],
                       ffn_w_gate[layer, 0], ffn_w_up[layer, 0], ffn_w_down[layer, 0])
        x_c = half_ffn(x_c, mod_c[0], mod_c[1], mod_c[2], norm_g[layer, 0],
                       ffn_w_gate[layer, 0], ffn_w_up[layer, 0], ffn_w_down[layer, 0])

        h_l = rmsnorm(x_l, norm_g[layer, 1]) * (1 + mod_l[:, 4]) + mod_l[:, 3]
        h_c = rmsnorm(x_c, norm_g[layer, 1]) * (1 + mod_c[4]) + mod_c[3]
        i = layer // 2
        if layer % 2 == 0:
            y_l, y_c = fourier_na_mixer(h_l, h_c, ab_w_in[i], ab_rpb[i], ab_w_out[i], not last)
        else:
            y_l, y_c = mla_mixer(h_l, h_c, mla_w_in[i], mla_g_q[i], mla_g_kv[i], mla_w_uq[i],
                                 mla_w_uk[i], mla_w_uv[i], mla_w_o[i], cos, sin, not last)
        x_l = x_l + mod_l[:, 5] * y_l

        x_l = half_ffn(x_l, mod_l[:, 6], mod_l[:, 7], mod_l[:, 8], norm_g[layer, 2],
                       ffn_w_gate[layer, 1], ffn_w_up[layer, 1], ffn_w_down[layer, 1])
        if not last:
            x_c = x_c + mod_c[5] * y_c
            x_c = half_ffn(x_c, mod_c[6], mod_c[7], mod_c[8], norm_g[layer, 2],
                           ffn_w_gate[layer, 1], ffn_w_up[layer, 1], ffn_w_down[layer, 1])
    return rmsnorm(x_l, final_g)
```

```cpp
#include <hip/hip_runtime.h>
#include <hip/hip_cooperative_groups.h>
#include <cstdio>
#include <cstdint>
namespace cg = cooperative_groups;
namespace pg8 {
#define PG8_LAS __attribute__((address_space(3)))
typedef unsigned short bf16_t;
typedef short bf16x8 __attribute__((ext_vector_type(8)));
typedef float f32x4 __attribute__((ext_vector_type(4)));
typedef unsigned u32x4 __attribute__((ext_vector_type(4)));
constexpr int BM = 256, BK = 64, HALF = 128, HTB = HALF * BK * 2  , STAGE_BYTES = 8 * HTB, NXCD = 8, WGM = 8;

__host__ __device__ __forceinline__ int lds_byte(int r, int c) { const int st = (r >> 4) * 2 + (c >> 5), rr = r & 15, cc = c & 31, ob = rr * 64 + cc * 2; return st * 1024 + (ob ^ (((ob >> 9) & 1) << 5)); }
__host__ __device__ __forceinline__ void stage_rc(int b, int& R, int& C) { const int st = b / 1024, sb = b % 1024, swz = sb ^ (((sb >> 9) & 1) << 5); R = (st >> 1) * 16 + swz / 64; C = (st & 1) * 32 + (swz % 64) / 2; }
__host__ __device__ __forceinline__ int perm32(int rho) { const int n = rho >> 4, i = rho & 15; return 8 * (i >> 2) + 4 * n + (i & 3); }

struct Unit { int pm, pn; };
struct Gemm { const bf16_t* A; const bf16_t* Bt; int M, N, K; };

struct StaticOrder {
    int nM, nN, nwg, G, c;
    __host__ __device__ __forceinline__ void init(int M, int N, int G_, int c_) { nM = M / BM; nN = N / BM; nwg = nM * nN; G = G_; c = c_; }
    __host__ __device__ __forceinline__ bool next(int i, Unit& u) const {
        const long L = (long)i * G + c; if (L >= nwg) return false;
        int wgid = (int)L; { const int q = nwg / NXCD, r = nwg % NXCD, xcd = wgid % NXCD, off = wgid / NXCD; wgid = (xcd < r ? xcd * (q + 1) : r * (q + 1) + (xcd - r) * q) + off; }
        const int nig = WGM * nN, gid = wgid / nig, fm = gid * WGM, gsz = (nM - fm) < WGM ? (nM - fm) : WGM;
        u.pm = fm + ((wgid % nig) % gsz); u.pn = (wgid % nig) / gsz; return true;
    }
    __device__ __forceinline__ void a_ready(const Unit&) const {}
    __device__ __forceinline__ void done(const Unit&) const {}
    __device__ __forceinline__ int kt0(const Unit&) const { return 0; }
    __device__ __forceinline__ int nkt(const Unit&, int full) const { return full; }
};

__device__ __forceinline__ unsigned cvt_pk_bf16(float lo, float hi) { unsigned r; asm volatile("v_cvt_pk_bf16_f32 %0, %1, %2" : "=v"(r) : "v"(lo), "v"(hi)); return r; }
typedef float f32x2 __attribute__((ext_vector_type(2)));
__device__ __forceinline__ f32x2 gelu_pk(f32x2 v) {
    const f32x2 av = __builtin_elementwise_abs(v), d = av * 0.2316418882f + 1.0f;
    f32x2 t; t.x = __builtin_amdgcn_rcpf(d.x); t.y = __builtin_amdgcn_rcpf(d.y);
    f32x2 q = t * 0.5307027145f + (-0.7265760135f); q = q * t + 0.7107068705f; q = q * t + (-0.142248368f); q = q * t + 0.127414796f; q = q * t;
    const f32x2 s = (v * v) * (-0.72134752044f);
    f32x2 e; e.x = __builtin_amdgcn_exp2f(s.x); e.y = __builtin_amdgcn_exp2f(s.y);
    const f32x2 m = v * (q * e), r = v - m;
    f32x2 o; o.x = v.x < 0.f ? m.x : r.x; o.y = v.y < 0.f ? m.y : r.y; return o;
}

template <int ACT  > struct EpiBf16 {
    static constexpr bool PERM = true, AFTER_DRAIN = false; static_assert(ACT == 0 || ACT == 1, "EpiBf16: ACT is 0 (none) or 1 (gelu_pk)");
    bf16_t* O; int ldc; const float* bias; int split_cols; size_t split_stride; float scale0;
    __device__ __forceinline__ void operator()(const f32x4 (&acc)[2][2][4][2], const Unit& u, int wr, int wc, int fr, int fq) const {
        const int row0 = u.pm * BM + wr * 64 + fr; int colt = u.pn * BM; bf16_t* base = O;
        float sc = 1.f; if (split_cols) { const int t = colt / split_cols; base += (size_t)t * split_stride; colt -= t * split_cols; if (t == 0) sc = scale0; }
        const int col0 = colt + wc * 32 + 8 * fq, bcol0 = u.pn * BM + wc * 32 + 8 * fq;
        f32x4 bv[2][2];
#pragma unroll
        for (int bj = 0; bj < 2; ++bj)
#pragma unroll
            for (int n = 0; n < 2; ++n) bv[bj][n] = bias ? *(const f32x4*)(bias + bcol0 + bj * HALF + 4 * n) : (f32x4){0.f, 0.f, 0.f, 0.f};
#pragma unroll
        for (int ai = 0; ai < 2; ++ai)
#pragma unroll
            for (int m = 0; m < 4; ++m) { bf16_t* rowp = base + (size_t)(row0 + ai * HALF + m * 16) * ldc + col0;
#pragma unroll
                for (int bj = 0; bj < 2; ++bj) { f32x4 v0 = acc[ai][bj][m][0] + bv[bj][0], v1 = acc[ai][bj][m][1] + bv[bj][1];
                    if (ACT == 1) { f32x2 a = gelu_pk((f32x2){v0[0], v0[1]}), b = gelu_pk((f32x2){v0[2], v0[3]}), c = gelu_pk((f32x2){v1[0], v1[1]}), d = gelu_pk((f32x2){v1[2], v1[3]});
                        v0 = (f32x4){a.x, a.y, b.x, b.y}; v1 = (f32x4){c.x, c.y, d.x, d.y}; }
                    v0 = v0 * sc; v1 = v1 * sc; u32x4 w; w.x = cvt_pk_bf16(v0[0], v0[1]); w.y = cvt_pk_bf16(v0[2], v0[3]); w.z = cvt_pk_bf16(v1[0], v1[1]); w.w = cvt_pk_bf16(v1[2], v1[3]);
                    *(u32x4*)(rowp + bj * HALF) = w; } }
    }
};
template <class Epi, class Sched, bool ALIGN_EPI = false, bool SP2 = false>
__device__ __forceinline__ void gemm_phase(PG8_LAS unsigned char* lds, const Gemm g, const Sched& S, const Epi& E) {
    int tid_ = threadIdx.x; asm volatile("" : "+v"(tid_));
    const int tid = tid_, wid = __builtin_amdgcn_readfirstlane(tid >> 6), lane = tid & 63, wr = wid >> 2, wc = wid & 3, fr = lane & 15, fq = lane >> 4;
    const int K = g.K, nt_full = K / BK;
    unsigned voffA[2], voffB[2];
#pragma unroll
    for (int i = 0; i < 2; ++i) { int R, C; stage_rc(tid * 16 + i * 8192, R, C); const int Rb = Epi::PERM ? ((R & ~31) + perm32(R & 31)) : R;
        voffA[i] = (unsigned)(R * K + C) * 2u; voffB[i] = (unsigned)(Rb * K + C) * 2u; }
    const size_t kstep = (size_t)(BK * 2);
    const size_t hstep = (size_t)HALF * K * 2;
    const size_t tstep = 2 * hstep;
    const unsigned ldsw = (unsigned)wid * 1024u;
    const int aoff = lds_byte(wr * 64 + fr, fq * 8), boff = lds_byte(wc * 32 + fr, fq * 8);
#define PG8_SA(b, h) (((b) * 2 + (h)) * HTB)
#define PG8_SB(b, h) ((4 + (b) * 2 + (h)) * HTB)
#define PG8_STAGE(bufoff, gbase, voff) do { _Pragma("unroll") for (int _i = 0; _i < 2; ++_i) \
        __builtin_amdgcn_global_load_lds((const unsigned*)((const char*)(gbase) + (voff)[_i]), (PG8_LAS unsigned*)(lds + (bufoff) + ldsw + _i * 8192), 16, 0, 0); } while (0)
#define PG8_LDA(dst, b, h) do { _Pragma("unroll") for (int m = 0; m < 4; ++m) _Pragma("unroll") for (int k = 0; k < 2; ++k) dst[m][k] = *(const PG8_LAS bf16x8*)(lds + PG8_SA(b, h) + aoff + m * 2048 + k * 1024); } while (0)
#define PG8_LDB(dst, b, h) do { _Pragma("unroll") for (int n = 0; n < 2; ++n) _Pragma("unroll") for (int k = 0; k < 2; ++k) dst[n][k] = *(const PG8_LAS bf16x8*)(lds + PG8_SB(b, h) + boff + n * 2048 + k * 1024); } while (0)
#define PG8_MMA(ai, bj, At, Bt) do { __builtin_amdgcn_s_setprio(1); _Pragma("unroll") for (int m = 0; m < 4; ++m) _Pragma("unroll") for (int n = 0; n < 2; ++n) _Pragma("unroll") for (int k = 0; k < 2; ++k) \
        acc[ai][bj][m][n] = __builtin_amdgcn_mfma_f32_16x16x32_bf16(Bt[n][k], At[m][k], acc[ai][bj][m][n], 0, 0, 0); __builtin_amdgcn_s_setprio(0); } while (0)
#define PG8_WAIT_V(n) asm volatile("s_waitcnt vmcnt(" #n ")" ::: "memory")
#define PG8_WAIT_L(n) asm volatile("s_waitcnt lgkmcnt(" #n ")" ::: "memory")
#define PG8_BAR __builtin_amdgcn_s_barrier()
#define PG8_SCHED __builtin_amdgcn_sched_barrier(0)
    Unit cur, nxt; int ui = 0;
    if (!S.next(0, cur)) return;
    f32x4 acc[2][2][4][2];
#pragma unroll
    for (int a = 0; a < 2; ++a)
#pragma unroll
        for (int b = 0; b < 2; ++b)
#pragma unroll
            for (int m = 0; m < 4; ++m)
#pragma unroll
                for (int n = 0; n < 2; ++n) acc[a][b][m][n] = (f32x4){0.f, 0.f, 0.f, 0.f};
    bf16x8 At[4][2], B0[2][2], B1[2][2];
    int nt = S.nkt(cur, nt_full);
    const char* cA = (const char*)g.A + (size_t)cur.pm * tstep + (size_t)S.kt0(cur) * kstep; const char* cB = (const char*)g.Bt + (size_t)(cur.pn & 255) * tstep + (size_t)S.kt0(cur) * kstep;
    S.a_ready(cur);
    if constexpr (SP2) {
        PG8_STAGE(PG8_SB(0, 0), cB, voffB); PG8_STAGE(PG8_SB(0, 1), cB + hstep, voffB); PG8_STAGE(PG8_SA(0, 0), cA, voffA); PG8_STAGE(PG8_SA(0, 1), cA + hstep, voffA);
        if (wr == 1) PG8_BAR;
        PG8_WAIT_V(2); PG8_BAR;
        PG8_STAGE(PG8_SB(1, 0), cB + kstep, voffB); PG8_STAGE(PG8_SA(1, 0), cA + kstep, voffA); PG8_STAGE(PG8_SB(1, 1), cB + hstep + kstep, voffB);
        PG8_WAIT_V(6); PG8_BAR;
    } else {
        PG8_STAGE(PG8_SB(0, 0), cB, voffB); PG8_STAGE(PG8_SA(0, 0), cA, voffA); PG8_STAGE(PG8_SB(0, 1), cB + hstep, voffB); PG8_STAGE(PG8_SA(0, 1), cA + hstep, voffA);
        if (wr == 1) PG8_BAR;
        PG8_WAIT_V(4); PG8_BAR;
        PG8_STAGE(PG8_SB(1, 0), cB + kstep, voffB); PG8_STAGE(PG8_SA(1, 0), cA + kstep, voffA); PG8_STAGE(PG8_SB(1, 1), cB + hstep + kstep, voffB);
        PG8_WAIT_V(6); PG8_BAR;
    }
    for (;;) {
        const bool has_next = S.next(ui + 1, nxt);
        const char* nA = has_next ? (const char*)g.A + (size_t)nxt.pm * tstep + (size_t)S.kt0(nxt) * kstep : cA; const char* nB = has_next ? (const char*)g.Bt + (size_t)(nxt.pn & 255) * tstep + (size_t)S.kt0(nxt) * kstep : cB;
        for (int t = 0; t < nt; t += 2) {
            const bool last = (t == nt - 2);
            const char* a1 = cA + (size_t)(t + 1) * kstep;
            const char* a2 = last ? nA : cA + (size_t)(t + 2) * kstep; const char* b2 = last ? nB : cB + (size_t)(t + 2) * kstep;
            const char* a3 = a2 + kstep; const char* b3 = b2 + kstep;
            if (last && has_next) S.a_ready(nxt);
            if constexpr (SP2) {
            PG8_LDB(B0, 0, 0); PG8_LDB(B1, 0, 1); PG8_SCHED; PG8_LDA(At, 0, 0); PG8_STAGE(PG8_SA(1, 1), a1 + hstep, voffA);
            PG8_WAIT_V(8); PG8_WAIT_L(0); PG8_BAR; PG8_MMA(0, 0, At, B0); PG8_MMA(0, 1, At, B1); PG8_BAR; PG8_SCHED;
            PG8_LDA(At, 0, 1); PG8_STAGE(PG8_SB(0, 0), b2, voffB); PG8_STAGE(PG8_SB(0, 1), b2 + hstep, voffB); PG8_STAGE(PG8_SA(0, 0), a2, voffA);
            PG8_WAIT_V(8); PG8_WAIT_L(0); PG8_BAR; PG8_MMA(1, 0, At, B0); PG8_MMA(1, 1, At, B1); PG8_BAR; PG8_SCHED;
            PG8_LDB(B0, 1, 0); PG8_LDB(B1, 1, 1); PG8_SCHED; PG8_LDA(At, 1, 0); PG8_STAGE(PG8_SA(0, 1), a2 + hstep, voffA);
            PG8_WAIT_V(8); PG8_WAIT_L(0); PG8_BAR; PG8_MMA(0, 0, At, B0); PG8_MMA(0, 1, At, B1); PG8_BAR; PG8_SCHED;
            PG8_LDA(At, 1, 1); PG8_STAGE(PG8_SB(1, 0), b3, voffB); PG8_STAGE(PG8_SB(1, 1), b3 + hstep, voffB); PG8_STAGE(PG8_SA(1, 0), a3, voffA);
            PG8_WAIT_V(8); PG8_WAIT_L(0); PG8_BAR; PG8_MMA(1, 0, At, B0); PG8_MMA(1, 1, At, B1); PG8_BAR; PG8_SCHED;
            } else {
            PG8_LDB(B0, 0, 0); PG8_SCHED; PG8_LDA(At, 0, 0); PG8_STAGE(PG8_SA(1, 1), a1 + hstep, voffA);
            PG8_WAIT_L(8); PG8_BAR; PG8_WAIT_L(0); PG8_MMA(0, 0, At, B0); PG8_BAR; PG8_SCHED;
            PG8_LDB(B1, 0, 1); PG8_STAGE(PG8_SB(0, 0), b2, voffB);
            PG8_BAR; PG8_WAIT_L(0); PG8_MMA(0, 1, At, B1); PG8_BAR;
            PG8_LDA(At, 0, 1); PG8_STAGE(PG8_SA(0, 0), a2, voffA);
            PG8_BAR; PG8_WAIT_L(0); PG8_MMA(1, 0, At, B0); PG8_BAR; PG8_SCHED;
            PG8_STAGE(PG8_SB(0, 1), b2 + hstep, voffB);
            PG8_WAIT_V(6); PG8_BAR; PG8_MMA(1, 1, At, B1); PG8_BAR;
            PG8_LDB(B0, 1, 0); PG8_SCHED; PG8_LDA(At, 1, 0); PG8_STAGE(PG8_SA(0, 1), a2 + hstep, voffA);
            PG8_WAIT_L(8); PG8_BAR; PG8_WAIT_L(0); PG8_MMA(0, 0, At, B0); PG8_BAR; PG8_SCHED;
            PG8_LDB(B1, 1, 1); PG8_STAGE(PG8_SB(1, 0), b3, voffB);
            PG8_BAR; PG8_WAIT_L(0); PG8_MMA(0, 1, At, B1); PG8_BAR;
            PG8_LDA(At, 1, 1); PG8_STAGE(PG8_SA(1, 0), a3, voffA);
            PG8_BAR; PG8_WAIT_L(0); PG8_MMA(1, 0, At, B0); PG8_BAR; PG8_SCHED;
            PG8_STAGE(PG8_SB(1, 1), b3 + hstep, voffB);
            PG8_WAIT_V(6); PG8_BAR; PG8_MMA(1, 1, At, B1); PG8_BAR;
            }
        }
        if constexpr (ALIGN_EPI) { if (wr == 0) PG8_BAR; }
        if constexpr (!Epi::AFTER_DRAIN) { E(acc, cur, wr, wc, fr, fq); S.done(cur); }
        if (!has_next) break;
#pragma unroll
        for (int a = 0; a < 2; ++a)
#pragma unroll
            for (int b = 0; b < 2; ++b)
#pragma unroll
                for (int m = 0; m < 4; ++m)
#pragma unroll
                    for (int n = 0; n < 2; ++n) acc[a][b][m][n] = (f32x4){0.f, 0.f, 0.f, 0.f};
        cur = nxt; cA = nA; cB = nB; ++ui; nt = S.nkt(cur, nt_full);
        if constexpr (ALIGN_EPI) { if (wr == 1) PG8_BAR; }
    }
    PG8_WAIT_V(0);
    if constexpr (!ALIGN_EPI) { if (wr == 0) PG8_BAR; }
    PG8_BAR;
    if constexpr (Epi::AFTER_DRAIN) { E.fused(acc, cur, wr, wc, fr, fq, lds, wid, lane); S.done(cur); }
#undef PG8_SA
#undef PG8_SB
#undef PG8_STAGE
#undef PG8_LDA
#undef PG8_LDB
#undef PG8_MMA
#undef PG8_WAIT_V
#undef PG8_WAIT_L
#undef PG8_BAR
#undef PG8_SCHED
}
}

constexpr int DM = 1024, NB = 8, SEQ = 4096, CTXL = 256, TPB = SEQ + CTXL  , MTOT = NB * TPB  , DFF = 2816;
constexpr int NMOD = 9;
constexpr float EPSN = 1e-6f;
constexpr float LOG2E = 1.4426950408889634f;
constexpr int NWAVES = 8;

constexpr size_t MiB = 1u << 20;
constexpr size_t WS_ROPE = 64 * 1024;
constexpr size_t WS_MOD = 1 * MiB;
constexpr size_t WS_W0 = 2 * MiB;
constexpr size_t SZ_WGU = (size_t)2 * DFF * DM * 2;
constexpr size_t SZ_WD = (size_t)DM * DFF * 2;
constexpr size_t W0_WGU0 = WS_W0, W0_WD0 = W0_WGU0 + SZ_WGU, W0_WGU1 = W0_WD0 + SZ_WD, W0_WD1 = W0_WGU1 + SZ_WGU;
constexpr size_t W0_WAB = W0_WD1 + SZ_WD;
constexpr size_t W0_WOUT = W0_WAB + (size_t)2560 * 1024 * 2;
constexpr size_t W0_END = W0_WOUT + (size_t)1024 * 1024 * 2;
static_assert(W0_END <= 42 * MiB, "W0");
constexpr size_t WS_DFTL = 42 * MiB;
constexpr size_t WS_DFTC = 106 * MiB;
constexpr size_t WS_W1 = 80 * MiB;
constexpr size_t W1_WGU0 = WS_W1, W1_WD0 = W1_WGU0 + SZ_WGU, W1_WGU1 = W1_WD0 + SZ_WD, W1_WD1 = W1_WGU1 + SZ_WGU;
constexpr size_t W1_WIN = W1_WD1 + SZ_WD;
constexpr size_t W1_WUQ = W1_WIN + (size_t)768 * 1024 * 2;
constexpr size_t W1_WUKV = W1_WUQ + (size_t)1536 * 384 * 2;
constexpr size_t W1_WO = W1_WUKV + (size_t)2048 * 256 * 2;
constexpr size_t W1_END = W1_WO + (size_t)1024 * 1536 * 2;
static_assert(W1_END <= 120 * MiB, "W1");
constexpr size_t WS_VB = 2 * MiB;
static_assert(WS_VB + (size_t)MTOT * 1024 * 2 <= WS_W1, "VB");
constexpr size_t WS_H = 120 * MiB;
constexpr size_t WS_A = 188 * MiB;
constexpr size_t WS_X = 375 * MiB;
constexpr size_t WS_END = WS_X + (size_t)MTOT * DM * 4;
static_assert(WS_END <= 512 * MiB, "ws");
static_assert(WS_A + (size_t)MTOT * DFF * 2 <= WS_X, "ACT");
constexpr size_t A_PQL = WS_A;
constexpr size_t A_PQC = WS_A + 64 * MiB;
constexpr size_t A_QN = WS_A + 68 * MiB;
constexpr size_t A_KNA = WS_A + 102 * MiB;
constexpr size_t A_VT = WS_A + 136 * MiB;
constexpr size_t A_Z = WS_A;
constexpr size_t A_QB = WS_A;
constexpr size_t A_CQ = WS_A + 102 * MiB;
constexpr size_t A_CKV = WS_A + 128 * MiB;
constexpr size_t A_KR = WS_A + 145 * MiB;
static_assert(A_KR + (size_t)MTOT * 64 * 2 <= WS_X, "A");

constexpr int LDS_BYTES = 135168;

typedef unsigned short bf16_t;
typedef short bf16x8 __attribute__((ext_vector_type(8)));
typedef float f32x4 __attribute__((ext_vector_type(4)));
typedef float f32x16 __attribute__((ext_vector_type(16)));
typedef unsigned u32x4 __attribute__((ext_vector_type(4)));
typedef unsigned u32x2 __attribute__((ext_vector_type(2)));
#define LAS __attribute__((address_space(3)))

__device__ __forceinline__ unsigned f2bf(float f) { unsigned u = __builtin_bit_cast(unsigned, f); return (u + 0x7fffu + ((u >> 16) & 1u)) >> 16; }
__device__ __forceinline__ unsigned pk2(float lo, float hi) { return pg8::cvt_pk_bf16(lo, hi); }
__device__ __forceinline__ float wave_sum(float v) {
#pragma unroll
    for (int o = 1; o < 64; o <<= 1) v += __shfl_xor(v, o);
    return v;
}
__device__ __forceinline__ float silu_f(float x) { return x * __builtin_amdgcn_rcpf(1.0f + __expf(-x)); }
__device__ __forceinline__ const float* in_row(const float* xin, const float* cin, int row) {
    const int b = row / TPB, t = row - b * TPB;
    return t < SEQ ? xin + ((size_t)b * SEQ + t) * DM : cin + ((size_t)b * CTXL + (t - SEQ)) * DM;
}

struct RotOrder {
    pg8::StaticOrder S;
    __device__ __forceinline__ void init(int M, int N, int G, int c, int rot) { S.init(M, N, G, (c + rot) % G); }
    __device__ __forceinline__ bool next(int i, pg8::Unit& u) const { return S.next(i, u); }
    __device__ __forceinline__ void a_ready(const pg8::Unit&) const {}
    __device__ __forceinline__ void done(const pg8::Unit&) const {}
    __device__ __forceinline__ int kt0(const pg8::Unit&) const { return 0; }
    __device__ __forceinline__ int nkt(const pg8::Unit&, int full) const { return full; }
};
constexpr int TAIL_ROW0 = 128 * 256, TAIL_ROWS = 8 * 256;
template <int NP> struct TailOrder {
    int G, c, ntk;
    __device__ __forceinline__ void init(int K, int G_, int c_) { G = G_; c = c_; ntk = K / 64; }
    __device__ __forceinline__ bool next(int i, pg8::Unit& u) const {
        const int L = i * G + c; if (L >= 32 * NP) return false;
        const int t = L / NP, p = L % NP;
        u.pm = 128 + (t & 7); u.pn = (t >> 3) | ((p + 1) << 8); return true;
    }
    __device__ __forceinline__ int kt0(const pg8::Unit& u) const { const int p = (u.pn >> 8) - 1, per2 = (ntk / 2) / NP, rem = (ntk / 2) % NP; return 2 * (p * per2 + (p < rem ? p : rem)); }
    __device__ __forceinline__ int nkt(const pg8::Unit& u, int full) const { const int p = (u.pn >> 8) - 1, per2 = (ntk / 2) / NP, rem = (ntk / 2) % NP; return 2 * (per2 + (p < rem ? 1 : 0)); }
    __device__ __forceinline__ void a_ready(const pg8::Unit&) const {}
    __device__ __forceinline__ void done(const pg8::Unit&) const {}
};
struct DftPieceOrder {
    pg8::StaticOrder S; int G, c;
    __device__ __forceinline__ void init(int G_, int c_) { S.init(2048, 4096, 1, 0); G = G_; c = c_; }
    __device__ __forceinline__ bool next(int i, pg8::Unit& u) const { const int L = i * G + c; if (L >= 256) return false; S.next(L >> 1, u); u.pn |= ((L & 1) + 1) << 8; return true; }
    __device__ __forceinline__ int kt0(const pg8::Unit& u) const { return ((u.pn >> 8) - 1) * 64; }
    __device__ __forceinline__ int nkt(const pg8::Unit&, int) const { return 64; }
    __device__ __forceinline__ void a_ready(const pg8::Unit&) const {}
    __device__ __forceinline__ void done(const pg8::Unit&) const {}
};
struct EpiEF {
    static constexpr bool PERM = false, AFTER_DRAIN = false;
    float* EF;
    __device__ __forceinline__ void operator()(const pg8::f32x4 (&acc)[2][2][4][2], const pg8::Unit& u, int wr, int wc, int fr, int fq) const {
        const int piece = (u.pn >> 8) - 1, pn = u.pn & 255;
        const int row0 = u.pm * 256 + wr * 64 + fr, col0 = pn * 256 + wc * 32 + 4 * fq;
        float* base = EF + (size_t)piece * 2048 * 4096;
#pragma unroll
        for (int ai = 0; ai < 2; ++ai)
#pragma unroll
            for (int m = 0; m < 4; ++m)
#pragma unroll
                for (int bj = 0; bj < 2; ++bj)
#pragma unroll
                    for (int n = 0; n < 2; ++n) *(f32x4*)(base + (size_t)(row0 + ai * 128 + m * 16) * 4096 + col0 + bj * 128 + n * 16) = acc[ai][bj][m][n];
    }
};
struct LatentOrder {
    pg8::StaticOrder S;
    __device__ __forceinline__ void init(int N, int G, int c) { S.init(NB * SEQ, N, G, c); }
    __device__ __forceinline__ bool next(int i, pg8::Unit& u) const { if (!S.next(i, u)) return false; u.pm = (u.pm >> 4) * 17 + (u.pm & 15); return true; }
    __device__ __forceinline__ void a_ready(const pg8::Unit&) const {}
    __device__ __forceinline__ void done(const pg8::Unit&) const {}
    __device__ __forceinline__ int kt0(const pg8::Unit&) const { return 0; }
    __device__ __forceinline__ int nkt(const pg8::Unit&, int full) const { return full; }
};

struct EpiSwiGLU {
    static constexpr bool PERM = true, AFTER_DRAIN = false;
    bf16_t* O;
    __device__ __forceinline__ void operator()(const pg8::f32x4 (&acc)[2][2][4][2], const pg8::Unit& u, int wr, int wc, int fr, int fq) const {
        const int row0 = u.pm * 256 + wr * 64 + fr, col0 = u.pn * 128 + wc * 32 + 8 * fq;
#pragma unroll
        for (int ai = 0; ai < 2; ++ai)
#pragma unroll
            for (int m = 0; m < 4; ++m) {
                const f32x4 g0 = acc[ai][0][m][0], g1 = acc[ai][0][m][1], u0 = acc[ai][1][m][0], u1 = acc[ai][1][m][1];
                u32x4 w;
                w.x = pk2(silu_f(g0[0]) * u0[0], silu_f(g0[1]) * u0[1]); w.y = pk2(silu_f(g0[2]) * u0[2], silu_f(g0[3]) * u0[3]);
                w.z = pk2(silu_f(g1[0]) * u1[0], silu_f(g1[1]) * u1[1]); w.w = pk2(silu_f(g1[2]) * u1[2], silu_f(g1[3]) * u1[3]);
                *(u32x4*)(O + (size_t)(row0 + ai * 128 + m * 16) * DFF + col0) = w;
            }
    }
};
struct EpiResid {
    static constexpr bool PERM = false, AFTER_DRAIN = false;
    float* X; const float* modL; int jgate; float coef;
    __device__ __forceinline__ void operator()(const pg8::f32x4 (&acc)[2][2][4][2], const pg8::Unit& u, int wr, int wc, int fr, int fq) const {
        const int row0 = u.pm * 256 + wr * 64 + fr, col0 = u.pn * 256 + wc * 32 + 4 * fq;
        const int b = u.pm / 17, isc = (u.pm - b * 17) == 16;
        const float* mrow = modL + ((size_t)(isc ? 8 : b) * NMOD + jgate) * DM;
        f32x4 gv[2][2];
#pragma unroll
        for (int bj = 0; bj < 2; ++bj)
#pragma unroll
            for (int n = 0; n < 2; ++n) gv[bj][n] = *(const f32x4*)(mrow + col0 + bj * 128 + n * 16) * coef;
#pragma unroll
        for (int ai = 0; ai < 2; ++ai)
#pragma unroll
            for (int m = 0; m < 4; ++m) {
                float* orow = X + (size_t)(row0 + ai * 128 + m * 16) * DM;
#pragma unroll
                for (int bj = 0; bj < 2; ++bj)
#pragma unroll
                    for (int n = 0; n < 2; ++n) {
                        const int c = col0 + bj * 128 + n * 16;
                        const f32x4 bs = *(const f32x4*)(orow + c);
                        *(f32x4*)(orow + c) = bs + gv[bj][n] * acc[ai][bj][m][n];
                    }
                if (m == 3) asm volatile("" ::: "memory");
            }
    }
};
struct EpiResidIn {
    static constexpr bool PERM = false, AFTER_DRAIN = false;
    const float* xin; const float* cin; float* X; const float* modL; int jgate; float coef;
    __device__ __forceinline__ void operator()(const pg8::f32x4 (&acc)[2][2][4][2], const pg8::Unit& u, int wr, int wc, int fr, int fq) const {
        const int row0 = u.pm * 256 + wr * 64 + fr, col0 = u.pn * 256 + wc * 32 + 4 * fq;
        const int b = u.pm / 17, isc = (u.pm - b * 17) == 16;
        const float* mrow = modL + ((size_t)(isc ? 8 : b) * NMOD + jgate) * DM;
        const float* src = isc ? cin + (size_t)b * CTXL * DM : xin + ((size_t)b * SEQ + (size_t)(u.pm - b * 17) * 256) * DM;
        f32x4 gv[2][2];
#pragma unroll
        for (int bj = 0; bj < 2; ++bj)
#pragma unroll
            for (int n = 0; n < 2; ++n) gv[bj][n] = *(const f32x4*)(mrow + col0 + bj * 128 + n * 16) * coef;
#pragma unroll
        for (int ai = 0; ai < 2; ++ai)
#pragma unroll
            for (int m = 0; m < 4; ++m) {
                const int rl = wr * 64 + fr + ai * 128 + m * 16;
                const float* brow = src + (size_t)rl * DM;
                float* orow = X + (size_t)(u.pm * 256 + rl) * DM;
#pragma unroll
                for (int bj = 0; bj < 2; ++bj)
#pragma unroll
                    for (int n = 0; n < 2; ++n) {
                        const int c = col0 + bj * 128 + n * 16;
                        const f32x4 bs = *(const f32x4*)(brow + c);
                        *(f32x4*)(orow + c) = bs + gv[bj][n] * acc[ai][bj][m][n];
                    }
                if (m == 3) asm volatile("" ::: "memory");
            }
    }
};
struct EpiPartial {
    static constexpr bool PERM = false, AFTER_DRAIN = false;
    float* P; const float* modL; int jgate; float coef;
    __device__ __forceinline__ void operator()(const pg8::f32x4 (&acc)[2][2][4][2], const pg8::Unit& u, int wr, int wc, int fr, int fq) const {
        const int piece = (u.pn >> 8) - 1, pn = u.pn & 255;
        const int row0 = (u.pm - 128) * 256 + wr * 64 + fr, col0 = pn * 256 + wc * 32 + 4 * fq;
        const int b = u.pm / 17, isc = (u.pm - b * 17) == 16;
        const float* mrow = modL + ((size_t)(isc ? 8 : b) * NMOD + jgate) * DM;
        float* pb = P + (size_t)piece * TAIL_ROWS * DM;
#pragma unroll
        for (int bj = 0; bj < 2; ++bj)
#pragma unroll
            for (int n = 0; n < 2; ++n) {
                const int c = col0 + bj * 128 + n * 16;
                const f32x4 gv = *(const f32x4*)(mrow + c) * coef;
#pragma unroll
                for (int ai = 0; ai < 2; ++ai)
#pragma unroll
                    for (int m = 0; m < 4; ++m) *(f32x4*)(pb + (size_t)(row0 + ai * 128 + m * 16) * DM + c) = gv * acc[ai][bj][m][n];
            }
    }
};
struct EpiPQT {
    static constexpr bool PERM = true, AFTER_DRAIN = false;
    bf16_t* PQl; bf16_t* PQc;
    __device__ __forceinline__ void operator()(const pg8::f32x4 (&acc)[2][2][4][2], const pg8::Unit& u, int wr, int wc, int fr, int fq) const {
        const int b = u.pn / 17, tt = u.pn - b * 17, isc = tt == 16;
        const int part = u.pm >> 1;
        const int j0 = (u.pm & 1) * 256 + wr * 64 + fr;
#pragma unroll
        for (int ai = 0; ai < 2; ++ai)
#pragma unroll
            for (int m = 0; m < 4; ++m) {
                const int j = j0 + ai * 128 + m * 16;
#pragma unroll
                for (int bj = 0; bj < 2; ++bj) {
                    const int tl = bj * 128 + wc * 32 + 8 * fq;
                    bf16_t* dst = isc ? PQc + ((size_t)(b * 512 + j) * 2 + part) * CTXL + tl
                                      : PQl + ((size_t)(b * 512 + j) * 2 + part) * SEQ + tt * 256 + tl;
                    const f32x4 v0 = acc[ai][bj][m][0], v1 = acc[ai][bj][m][1];
                    u32x4 w; w.x = pk2(v0[0], v0[1]); w.y = pk2(v0[2], v0[3]); w.z = pk2(v1[0], v1[1]); w.w = pk2(v1[2], v1[3]);
                    *(u32x4*)dst = w;
                }
            }
    }
};
struct EpiDFT {
    static constexpr bool PERM = true, AFTER_DRAIN = false;
    bf16_t* CAT; int tok_off;
    __device__ __forceinline__ void operator()(const pg8::f32x4 (&acc)[2][2][4][2], const pg8::Unit& u, int wr, int wc, int fr, int fq) const {
        const int k0 = u.pm * 256 + wr * 64 + fr;
#pragma unroll
        for (int ai = 0; ai < 2; ++ai)
#pragma unroll
            for (int m = 0; m < 4; ++m) {
                const int k = k0 + ai * 128 + m * 16;
#pragma unroll
                for (int bj = 0; bj < 2; ++bj) {
                    const int c = u.pn * 256 + bj * 128 + wc * 32 + 8 * fq, b = c >> 9, j = c & 511;
                    const f32x4 v0 = acc[ai][bj][m][0], v1 = acc[ai][bj][m][1];
                    u32x4 w; w.x = pk2(v0[0], v0[1]); w.y = pk2(v0[2], v0[3]); w.z = pk2(v1[0], v1[1]); w.w = pk2(v1[2], v1[3]);
                    *(u32x4*)(CAT + (size_t)(b * TPB + tok_off + k) * 1024 + j) = w;
                }
            }
    }
};
struct EpiZ {
    static constexpr bool PERM = false, AFTER_DRAIN = false;
    float* Z;
    __device__ __forceinline__ void operator()(const pg8::f32x4 (&acc)[2][2][4][2], const pg8::Unit& u, int wr, int wc, int fr, int fq) const {
        const int row0 = u.pm * 256 + wr * 64 + fr, col0 = u.pn * 256 + wc * 32 + 4 * fq;
#pragma unroll
        for (int ai = 0; ai < 2; ++ai)
#pragma unroll
            for (int m = 0; m < 4; ++m)
#pragma unroll
                for (int bj = 0; bj < 2; ++bj)
#pragma unroll
                    for (int n = 0; n < 2; ++n) {
                        const int c = col0 + bj * 128 + n * 16;
                        if (c < 576) *(f32x4*)(Z + (size_t)(row0 + ai * 128 + m * 16) * 576 + c) = acc[ai][bj][m][n];
                    }
    }
};
struct EpiQRope {
    static constexpr bool PERM = false, AFTER_DRAIN = false;
    bf16_t* QB; const float* cosT; const float* sinT;
    __device__ __forceinline__ void operator()(const pg8::f32x4 (&acc)[2][2][4][2], const pg8::Unit& u, int wr, int wc, int fr, int fq) const {
        const int row0 = u.pm * 256 + wr * 64 + fr;
#pragma unroll
        for (int ai = 0; ai < 2; ++ai)
#pragma unroll
            for (int m = 0; m < 4; ++m) {
                const int row = row0 + ai * 128 + m * 16, t = row % TPB, gr = (t >> 6) & 63, gc = t & 63;
#pragma unroll
                for (int bj = 0; bj < 2; ++bj) {
                    const int cbase = u.pn * 256 + bj * 128 + wc * 32, g6 = (cbase % 192) >> 5;
                    f32x4 v0 = acc[ai][bj][m][0], v1 = acc[ai][bj][m][1];
                    if (g6 >= 4) {
                        const int pos = (g6 == 4) ? gr : gc;
                        const f32x4 c4 = *(const f32x4*)(cosT + pos * 16 + 4 * fq), s4 = *(const f32x4*)(sinT + pos * 16 + 4 * fq);
                        const f32x4 a = v0, bb = v1;
                        v0 = a * c4 - bb * s4; v1 = bb * c4 + a * s4;
                    }
                    bf16_t* dst = QB + (size_t)row * 1536 + cbase + 4 * fq;
                    u32x2 w0, w1; w0.x = pk2(v0[0], v0[1]); w0.y = pk2(v0[2], v0[3]); w1.x = pk2(v1[0], v1[1]); w1.y = pk2(v1[2], v1[3]);
                    *(u32x2*)dst = w0; *(u32x2*)(dst + 16) = w1;
                }
            }
    }
};

#define LDS_WAIT() asm volatile("s_waitcnt lgkmcnt(0)" ::: "memory")

__device__ __forceinline__ void norm_pass(const float* X, const float* xin, const float* cin, const float* g, const float* modL, int jshift, int jscale,
                                          bf16_t* H, bool latent_only, int gw, int NGW, int lane, float* Xcopy = nullptr, const float* Pbuf = nullptr, int npieces = 0) {
    f32x4 vn[4];
    if (gw < MTOT) { const float* s0 = X ? X + (size_t)gw * DM : in_row(xin, cin, gw);
#pragma unroll
        for (int j = 0; j < 4; ++j) vn[j] = *(const f32x4*)(s0 + 4 * lane + 256 * j); }
#pragma unroll 1
    for (int row = gw; row < MTOT; row += NGW) {
        f32x4 v[4];
#pragma unroll
        for (int j = 0; j < 4; ++j) v[j] = vn[j];
        const int nrow = row + NGW;
        if (nrow < MTOT) { const float* s1 = X ? X + (size_t)nrow * DM : in_row(xin, cin, nrow);
#pragma unroll
            for (int j = 0; j < 4; ++j) vn[j] = *(const f32x4*)(s1 + 4 * lane + 256 * j); }
        const int b = row / TPB, t = row - b * TPB; const bool isc = t >= SEQ;
        if (latent_only && isc) continue;
        const float* mrow = modL + (size_t)(isc ? 8 : b) * NMOD * DM;
        f32x4 gs[4], sh[4];
#pragma unroll
        for (int j = 0; j < 4; ++j) { const int c = 4 * lane + 256 * j; gs[j] = *(const f32x4*)(g + c) * (*(const f32x4*)(mrow + jscale * DM + c) + 1.0f); sh[j] = *(const f32x4*)(mrow + jshift * DM + c); }
        const bool tail = row >= TAIL_ROW0;
        if (Pbuf && tail) {
            for (int p = 0; p < npieces; ++p) {
#pragma unroll
                for (int j = 0; j < 4; ++j) v[j] += *(const f32x4*)(Pbuf + ((size_t)p * TAIL_ROWS + (row - TAIL_ROW0)) * DM + 4 * lane + 256 * j);
            }
        }
        float ss = 0.f;
#pragma unroll
        for (int j = 0; j < 4; ++j) ss += (v[j][0] * v[j][0] + v[j][1] * v[j][1]) + (v[j][2] * v[j][2] + v[j][3] * v[j][3]);
        const float rstd = 1.0f / sqrtf(wave_sum(ss) * (1.0f / DM) + EPSN);
        if (Xcopy && tail && (X == nullptr || Pbuf)) {
#pragma unroll
            for (int j = 0; j < 4; ++j) *(f32x4*)(Xcopy + (size_t)row * DM + 4 * lane + 256 * j) = v[j];
        }
#pragma unroll
        for (int j = 0; j < 4; ++j) {
            const int c = 4 * lane + 256 * j;
            const f32x4 y = (v[j] * rstd) * gs[j] + sh[j];
            u32x2 w; w.x = pk2(y[0], y[1]); w.y = pk2(y[2], y[3]);
            *(u32x2*)(H + (size_t)row * DM + c) = w;
        }
    }
}
__device__ __forceinline__ void final_norm(const float* X, const float* g, float* out, int gw, int NGW, int lane) {
    f32x4 vn[4], g4[4];
#pragma unroll
    for (int j = 0; j < 4; ++j) g4[j] = *(const f32x4*)(g + 4 * lane + 256 * j);
    if (gw < NB * SEQ) { const int b0 = gw / SEQ; const float* s0 = X + (size_t)(b0 * TPB + (gw - b0 * SEQ)) * DM;
#pragma unroll
        for (int j = 0; j < 4; ++j) vn[j] = *(const f32x4*)(s0 + 4 * lane + 256 * j); }
#pragma unroll 1
    for (int r = gw; r < NB * SEQ; r += NGW) {
        f32x4 v[4]; float ss = 0.f;
#pragma unroll
        for (int j = 0; j < 4; ++j) v[j] = vn[j];
        const int nr = r + NGW;
        if (nr < NB * SEQ) { const int b1 = nr / SEQ; const float* s1 = X + (size_t)(b1 * TPB + (nr - b1 * SEQ)) * DM;
#pragma unroll
            for (int j = 0; j < 4; ++j) vn[j] = *(const f32x4*)(s1 + 4 * lane + 256 * j); }
#pragma unroll
        for (int j = 0; j < 4; ++j) ss += (v[j][0] * v[j][0] + v[j][1] * v[j][1]) + (v[j][2] * v[j][2] + v[j][3] * v[j][3]);
        const float rstd = 1.0f / sqrtf(wave_sum(ss) * (1.0f / DM) + EPSN);
#pragma unroll
        for (int j = 0; j < 4; ++j) { const int c = 4 * lane + 256 * j; *(f32x4*)(out + (size_t)r * DM + c) = (v[j] * rstd) * g4[j]; }
    }
}
__device__ __forceinline__ void mla_norm_pass(const float* Z, const float* gq, const float* gkv, const float* cosT, const float* sinT,
                                              bf16_t* CQ, bf16_t* CKV, bf16_t* KR, int gw, int NGW, int lane) {
    float zn[9];
    if (gw < MTOT) {
#pragma unroll
        for (int i = 0; i < 9; ++i) zn[i] = Z[(size_t)gw * 576 + lane + 64 * i]; }
#pragma unroll 1
    for (int row = gw; row < MTOT; row += NGW) {
        const int t = row % TPB; const bool isc = t >= SEQ;
        float q[6], kv[2]; float sq = 0.f, sk = 0.f;
#pragma unroll
        for (int i = 0; i < 6; ++i) { q[i] = zn[i]; sq += q[i] * q[i]; }
#pragma unroll
        for (int i = 0; i < 2; ++i) { kv[i] = zn[6 + i]; sk += kv[i] * kv[i]; }
        const float kr = zn[8];
        if (row + NGW < MTOT) {
#pragma unroll
            for (int i = 0; i < 9; ++i) zn[i] = Z[(size_t)(row + NGW) * 576 + lane + 64 * i]; }
        const float rq = 1.0f / sqrtf(wave_sum(sq) * (1.0f / 384.0f) + EPSN), rk = 1.0f / sqrtf(wave_sum(sk) * (1.0f / 128.0f) + EPSN);
#pragma unroll
        for (int i = 0; i < 6; ++i) CQ[(size_t)row * 384 + lane + 64 * i] = (bf16_t)f2bf(q[i] * rq * gq[lane + 64 * i]);
#pragma unroll
        for (int i = 0; i < 2; ++i) { CKV[(size_t)row * 256 + lane + 64 * i] = (bf16_t)f2bf(kv[i] * rk * gkv[lane + 64 * i]); CKV[(size_t)row * 256 + 128 + lane + 64 * i] = 0; }
        const float pr = __shfl_xor(kr, 16);
        float o = kr;
        if (!isc) {
            const int pos = (lane < 32) ? (t >> 6) : (t & 63), j = lane & 15;
            const float c = cosT[pos * 16 + j], s = sinT[pos * 16 + j];
            o = (lane & 16) ? (kr * c + pr * s) : (kr * c - pr * s);
        }
        KR[(size_t)row * 64 + lane] = (bf16_t)f2bf(o);
    }
}

__device__ __forceinline__ void tr_item(const float* W, int ldn, int k0, int n0, bf16_t* dst, int ldw, LAS float* scr, int lane) {
#pragma unroll 16
    for (int i = 0; i < 32; ++i) { const int kk = 2 * i + (lane >> 5); scr[kk * 33 + (lane & 31)] = W[(size_t)(k0 + kk) * ldn + n0 + (lane & 31)]; }
    LDS_WAIT(); asm volatile("" ::: "memory");
    const int c = lane & 7;
#pragma unroll
    for (int j = 0; j < 4; ++j) { const int n = (lane >> 3) + 8 * j; const LAS float* s = scr + (8 * c) * 33 + n;
        u32x4 o; o.x = pk2(s[0 * 33], s[1 * 33]); o.y = pk2(s[2 * 33], s[3 * 33]); o.z = pk2(s[4 * 33], s[5 * 33]); o.w = pk2(s[6 * 33], s[7 * 33]);
        *(u32x4*)(dst + (size_t)n * ldw + 8 * c) = o; }
    LDS_WAIT(); asm volatile("" ::: "memory");
}
struct MapPlain { bf16_t* dst; int ldw; __device__ __forceinline__ bf16_t* operator()(int n0, int k0) const { return dst + (size_t)n0 * ldw + k0; } };
struct MapGU { bf16_t* dst; int which; static constexpr int ldw = 1024; __device__ __forceinline__ bf16_t* operator()(int n0, int k0) const { return dst + (size_t)((n0 >> 7) * 256 + which * 128 + (n0 & 127)) * 1024 + k0; } };
struct MapWo { bf16_t* dst; static constexpr int ldw = 1536; __device__ __forceinline__ bf16_t* operator()(int n0, int k0) const { return dst + (size_t)n0 * 1536 + (k0 >> 7) * 192 + (k0 & 127); } };
template <class Map> __device__ __forceinline__ void conv_w(const float* W, int ldn, int K, int N, const Map mp, LAS float* scr, int gw, int NGW, int lane, int rot) {
    const int nblk = N / 32, nitems = (K / 64) * nblk;
    for (int it = (gw + rot) % NGW; it < nitems; it += NGW) { const int kb = it / nblk, nb = it - kb * nblk; tr_item(W, ldn, 64 * kb, 32 * nb, mp(32 * nb, 64 * kb), mp.ldw, scr, lane); }
}
__device__ __forceinline__ void conv_ffn(const float* wg, const float* wu, const float* wd, int layer, unsigned char* ws, size_t off_gu0, size_t off_d0, size_t off_gu1, size_t off_d1,
                                         LAS float* scr, int gw, int NGW, int lane) {
#pragma unroll 1
    for (int f = 0; f < 2; ++f) {
        const size_t lf = (size_t)(layer * 2 + f);
        bf16_t* gu = (bf16_t*)(ws + (f ? off_gu1 : off_gu0)); bf16_t* d = (bf16_t*)(ws + (f ? off_d1 : off_d0));
        conv_w(wg + lf * DM * DFF, DFF, DM, DFF, MapGU{gu, 0}, scr, gw, NGW, lane, 0);
        conv_w(wu + lf * DM * DFF, DFF, DM, DFF, MapGU{gu, 1}, scr, gw, NGW, lane, 1408);
        conv_w(wd + lf * DFF * DM, DM, DFF, DM, MapPlain{d, DFF}, scr, gw, NGW, lane, 768);
    }
}

__device__ __forceinline__ void fold_pq(const float* w_in  , bf16_t* Wab, LAS float* tab  , int gw, int NGW, int lane) {
    for (int it = gw; it < 2048; it += NGW) {
        const int kb = it & 127, mh = (it >> 7) & 1, part = (it >> 8) & 1, g = it >> 9;
        const int m = mh * 64 + lane, k0 = kb * 8;
        float acc[8];
#pragma unroll
        for (int i = 0; i < 8; ++i) acc[i] = 0.f;
        const float* wp = w_in + (size_t)k0 * 2048 + g * 128;
#pragma unroll 8
        for (int c = 0; c < 128; ++c) {
            const float tv = tab[part * 128 + ((m * c) & 127)];
#pragma unroll
            for (int i = 0; i < 8; ++i) acc[i] += wp[(size_t)i * 2048 + c] * tv;
        }
        const float sc = 0.08838834764831845f;
        bf16_t* dst = Wab + (size_t)(part * 512 + g * 128 + m) * 1024 + k0;
        u32x4 w0;
        w0.x = pk2(acc[0] * sc, acc[1] * sc); w0.y = pk2(acc[2] * sc, acc[3] * sc); w0.z = pk2(acc[4] * sc, acc[5] * sc); w0.w = pk2(acc[6] * sc, acc[7] * sc);
        *(u32x4*)dst = w0;
    }
}
__device__ __forceinline__ void gen_dft(bf16_t* D, int N, int logN, float s, int nrows, float sgn, long gtid, long NT) {
    const long nchunk = (long)nrows * 2 * N / 8;
    for (long ch = gtid; ch < nchunk; ch += NT) {
        const long e0 = ch * 8; const int k = (int)(e0 >> (logN + 1)), kk0 = (int)(e0 & (2 * N - 1));
        const bool sn = kk0 >= N; const int n0 = sn ? kk0 - N : kk0;
        float v[8];
#pragma unroll
        for (int i = 0; i < 8; ++i) { const int idx = (k * (n0 + i)) & (N - 1); const float a = (float)idx * (2.0f / (float)N);
            v[i] = sn ? sgn * sinpif(a) * s : cospif(a) * s; }
        u32x4 w; w.x = pk2(v[0], v[1]); w.y = pk2(v[2], v[3]); w.z = pk2(v[4], v[5]); w.w = pk2(v[6], v[7]);
        *(u32x4*)(D + e0) = w;
    }
}
__device__ __forceinline__ void dft_combine(const float* EF, bf16_t* CAT, long gtid, long NT) {
    for (long it = gtid; it < 2048L * 1024; it += NT) {
        const int k = (int)(it >> 10), c = (int)(it & 1023) * 4, b = c >> 9, j = c & 511;
        const f32x4 e = *(const f32x4*)(EF + (size_t)k * 4096 + c), f = *(const f32x4*)(EF + ((size_t)2048 + k) * 4096 + c);
        const f32x4 d = e - f, a = e + f;
        u32x2 w; w.x = pk2(d[0], d[1]); w.y = pk2(d[2], d[3]);
        *(u32x2*)(CAT + (size_t)(b * TPB + k) * 1024 + j) = w;
        if (k) { u32x2 w2; w2.x = pk2(a[0], a[1]); w2.y = pk2(a[2], a[3]); *(u32x2*)(CAT + (size_t)(b * TPB + 4096 - k) * 1024 + j) = w2; }
    }
}
__device__ __forceinline__ void dft_nyquist(const bf16_t* PQl, bf16_t* CAT, int gw, int NGW, int lane) {
    for (int it = gw; it < 4096; it += NGW) {
        const bf16_t* p = PQl + (size_t)it * 2 * 4096;
        float s = 0.f;
#pragma unroll
        for (int i = 0; i < 8; ++i) { const u32x4 v = *(const u32x4*)(p + (lane + 64 * i) * 8);
#pragma unroll
            for (int q = 0; q < 4; ++q) { const unsigned w = v[q]; s += __builtin_bit_cast(float, w << 16) - __builtin_bit_cast(float, w & 0xffff0000u); } }
        s = wave_sum(s);
        if (lane == 0) CAT[(size_t)((it >> 9) * TPB + 2048) * 1024 + (it & 511)] = (bf16_t)f2bf(s * (1.0f / 64.0f));
    }
}
__device__ __forceinline__ void mod_gemv(const float* c, const float* cctx, const float* ada_w, const float* ada_b, float* mod, LAS float* lds, int tid, int bx, int G) {
    LAS float* s = lds; LAS float* part = lds + 9 * 1024;
    for (int i = tid; i < 9 * 1024; i += 512) { const float v = (i < 8 * 1024) ? c[i] : cctx[i - 8 * 1024]; s[i] = silu_f(v); }
    __syncthreads();
    const int wave = tid >> 6, lane = tid & 63;
    for (int unit = bx; unit < 2 * 128; unit += G) {
        const int layer = unit >> 7, ch = unit & 127;
        const float* W0 = ada_w + (size_t)layer * DM * 9216 + ch * 72 + lane;
        const float* W1 = ada_w + (size_t)layer * DM * 9216 + ch * 72 + 64 + (lane & 7);
        float a0[9], a1[9];
#pragma unroll
        for (int m = 0; m < 9; ++m) { a0[m] = 0.f; a1[m] = 0.f; }
#pragma unroll 16
        for (int kk = 0; kk < 128; ++kk) { const int k = wave * 128 + kk; const float w0 = W0[(size_t)k * 9216], w1 = W1[(size_t)k * 9216];
#pragma unroll
            for (int m = 0; m < 9; ++m) { const float sv = s[m * 1024 + k]; a0[m] += sv * w0; a1[m] += sv * w1; } }
#pragma unroll
        for (int m = 0; m < 9; ++m) { part[(wave * 9 + m) * 72 + lane] = a0[m]; if (lane < 8) part[(wave * 9 + m) * 72 + 64 + lane] = a1[m]; }
        __syncthreads();
        for (int o = tid; o < 9 * 72; o += 512) { const int m = o / 72, l = o - m * 72; float a = 0.f;
#pragma unroll
            for (int w = 0; w < 8; ++w) a += part[(w * 9 + m) * 72 + l];
            mod[((size_t)layer * 9 + m) * 9216 + ch * 72 + l] = a + ada_b[(size_t)layer * 9216 + ch * 72 + l]; }
        __syncthreads();
    }
}

__device__ __forceinline__ int crow(int r, int hi) { return (r & 3) + 8 * (r >> 2) + 4 * hi; }
struct NaFragK { bf16x8 k0[4], k1[4]; };
struct NaFragV { bf16x8 v[8]; };
__device__ __forceinline__ void na_load_k(NaFragK& f, const bf16_t* Kb, int krow0, int h, int r32, int hi) {
#pragma unroll
    for (int d0 = 0; d0 < 4; ++d0) {
        f.k0[d0] = *(const bf16x8*)(Kb + (size_t)(krow0 + r32) * 512 + h * 64 + d0 * 16 + hi * 8);
        f.k1[d0] = *(const bf16x8*)(Kb + (size_t)(krow0 + 32 + r32) * 512 + h * 64 + d0 * 16 + hi * 8);
    }
}
__device__ __forceinline__ void na_load_v(NaFragV& f, const bf16_t* Vb, int krow0, int h, int lane) {
#pragma unroll
    for (int j = 0; j < 8; ++j) f.v[j] = *(const bf16x8*)(Vb + (size_t)(krow0 + (lane >> 3) + 8 * j) * 512 + h * 64 + (lane & 7) * 8);
}
__device__ __forceinline__ int nav_st(int k, int c) { const int kk = (k & ~0xC) | ((k & 4) << 1) | ((k & 8) >> 1); return ((kk >> 3) * 2 + (c >> 5)) * 512 + ((kk & 7) * 32 + (c & 31)) * 2; }
__device__ __forceinline__ int nav_rd_base(int lane) { return ((lane & 3) << 3) | (((lane >> 2) & 3) << 6) | (((lane >> 4) & 1) << 5) | (((lane >> 5) & 1) << 8); }
constexpr int nav_rd_off(int db, int ks, int half) { return db * 512 + ks * 2048 + half * 1024; }
typedef short s16x4_na __attribute__((ext_vector_type(4)));
template <int OFF> __device__ __forceinline__ s16x4_na nav_tr(int vb) { s16x4_na r; asm volatile("ds_read_b64_tr_b16 %0, %1 offset:%2" : "=&v"(r) : "v"(vb), "i"(OFF) : "memory"); return r; }
template <int DB, int KS> __device__ __forceinline__ bf16x8 nav_frag(int vb) {
    const s16x4_na l = nav_tr<nav_rd_off(DB, KS, 0)>(vb), hh = nav_tr<nav_rd_off(DB, KS, 1)>(vb);
    return (bf16x8){l[0], l[1], l[2], l[3], hh[0], hh[1], hh[2], hh[3]};
}
template <bool WIN>
__device__ __forceinline__ void na_compute(const NaFragK& f, const NaFragV& fv, const bf16x8 (&qr)[4], f32x16 (&o)[2], float& mrun, float& lrun, const LAS float* rpb_h,
                                           bool win, int t, int r0, int r, int qc, int cs, int hi, LAS char* vlds, int lane) {
    const float C = 0.125f * LOG2E;
    f32x16 p0, p1;
#pragma unroll
    for (int i = 0; i < 16; ++i) { p0[i] = 0.f; p1[i] = 0.f; }
#pragma unroll
    for (int d0 = 0; d0 < 4; ++d0) {
        p0 = __builtin_amdgcn_mfma_f32_32x32x16_bf16(f.k0[d0], qr[d0], p0, 0, 0, 0);
        p1 = __builtin_amdgcn_mfma_f32_32x32x16_bf16(f.k1[d0], qr[d0], p1, 0, 0, 0);
    }
    if (win) {
        const int ro = r0 + t - r + 7;
        const LAS float* bp = rpb_h + ro * 128 + 48;
        int qc_ = 15 - qc + 4 * hi, cs_ = cs - 4 * hi; asm volatile("" : "+v"(qc_), "+v"(cs_));
#pragma unroll
        for (int i = 0; i < 16; ++i) {
            const int kq = (i & 3) + 8 * (i >> 2);
            const float b0 = bp[kq + qc_], b1 = bp[kq + 32 + qc_];
            p0[i] = ((unsigned)(kq - cs_) < 16u) ? fmaf(p0[i], C, b0) : -INFINITY;
            p1[i] = ((unsigned)(kq + 32 - cs_) < 16u) ? fmaf(p1[i], C, b1) : -INFINITY;
        }
    } else {
#pragma unroll
        for (int i = 0; i < 16; ++i) { p0[i] *= C; p1[i] *= C; }
    }
    float pm = p0[0];
#pragma unroll
    for (int i = 1; i < 16; ++i) pm = fmaxf(pm, p0[i]);
#pragma unroll
    for (int i = 0; i < 16; ++i) pm = fmaxf(pm, p1[i]);
    pm = fmaxf(pm, __shfl_xor(pm, 32));
    const float mn = fmaxf(mrun, pm), alpha = __builtin_amdgcn_exp2f(mrun - mn);
    mrun = mn;
    float ps = 0.f;
#pragma unroll
    for (int i = 0; i < 16; ++i) { p0[i] = __builtin_amdgcn_exp2f(p0[i] - mn); p1[i] = __builtin_amdgcn_exp2f(p1[i] - mn); ps += p0[i] + p1[i]; }
    ps += __shfl_xor(ps, 32);
    lrun = lrun * alpha + ps;
#pragma unroll
    for (int i = 0; i < 16; ++i) { o[0][i] *= alpha; o[1][i] *= alpha; }
#pragma unroll
    for (int j = 0; j < 8; ++j) *(LAS bf16x8*)(vlds + nav_st((lane >> 3) + 8 * j, (lane & 7) * 8)) = fv.v[j];
    bf16x8 pbf[4];
#define NA_PK4(P, BASE, OUT) do { unsigned a0 = pk2(P[BASE + 0], P[BASE + 1]), a1 = pk2(P[BASE + 2], P[BASE + 3]);   \
    unsigned b0 = pk2(P[BASE + 4], P[BASE + 5]), b1 = pk2(P[BASE + 6], P[BASE + 7]);                              \
    auto r0_ = __builtin_amdgcn_permlane32_swap(a0, b0, false, false); auto r1_ = __builtin_amdgcn_permlane32_swap(a1, b1, false, false); \
    u32x4 w_ = {r0_[0], r1_[0], r0_[1], r1_[1]}; OUT = __builtin_bit_cast(bf16x8, w_); } while (0)
    NA_PK4(p0, 0, pbf[0]); NA_PK4(p0, 8, pbf[1]); NA_PK4(p1, 0, pbf[2]); NA_PK4(p1, 8, pbf[3]);
#undef NA_PK4
    const int vb = (int)(unsigned)(uintptr_t)vlds + nav_rd_base(lane);
    const bf16x8 a00 = nav_frag<0, 0>(vb), a10 = nav_frag<1, 0>(vb), a01 = nav_frag<0, 1>(vb), a11 = nav_frag<1, 1>(vb);
    const bf16x8 a02 = nav_frag<0, 2>(vb), a12 = nav_frag<1, 2>(vb), a03 = nav_frag<0, 3>(vb), a13 = nav_frag<1, 3>(vb);
    asm volatile("s_waitcnt lgkmcnt(0)" ::: "memory"); __builtin_amdgcn_sched_barrier(0);
    o[0] = __builtin_amdgcn_mfma_f32_32x32x16_bf16(a00, pbf[0], o[0], 0, 0, 0); o[1] = __builtin_amdgcn_mfma_f32_32x32x16_bf16(a10, pbf[0], o[1], 0, 0, 0);
    o[0] = __builtin_amdgcn_mfma_f32_32x32x16_bf16(a01, pbf[1], o[0], 0, 0, 0); o[1] = __builtin_amdgcn_mfma_f32_32x32x16_bf16(a11, pbf[1], o[1], 0, 0, 0);
    o[0] = __builtin_amdgcn_mfma_f32_32x32x16_bf16(a02, pbf[2], o[0], 0, 0, 0); o[1] = __builtin_amdgcn_mfma_f32_32x32x16_bf16(a12, pbf[2], o[1], 0, 0, 0);
    o[0] = __builtin_amdgcn_mfma_f32_32x32x16_bf16(a03, pbf[3], o[0], 0, 0, 0); o[1] = __builtin_amdgcn_mfma_f32_32x32x16_bf16(a13, pbf[3], o[1], 0, 0, 0);
}
template <bool WIN>
__device__ __forceinline__ void na_unit(const bf16_t* Q, const bf16_t* Kb, const bf16_t* Vb, bf16_t* CAT, const LAS float* rpb_h, int b, int h, int qrow0, int r, int qc0, int lane, LAS char* vlds) {
    const int r32 = lane & 31, hi = lane >> 5;
    bf16x8 qr[4];
#pragma unroll
    for (int d0 = 0; d0 < 4; ++d0) qr[d0] = *(const bf16x8*)(Q + (size_t)(qrow0 + r32) * 512 + h * 64 + d0 * 16 + hi * 8);
    float mrun = -1e30f, lrun = 0.f; f32x16 o[2];
#pragma unroll
    for (int i = 0; i < 16; ++i) { o[0][i] = 0.f; o[1][i] = 0.f; }
    int r0 = r - 4; r0 = r0 < 0 ? 0 : (r0 > 56 ? 56 : r0);
    const int qc = qc0 + r32; int cs = qc - 8; cs = cs < 0 ? 0 : (cs > 48 ? 48 : cs);
    int ua = 0, nwin = 0;
    if (WIN) { ua = r0; nwin = 8; }
    const int nst = nwin + 4;
#define NA_KROW(s) (b * TPB + ((s) < nwin ? (ua + (s)) * 64 : SEQ + ((s) - nwin) * 64))
#define NA_STEP(FK, FV, s) do { const int s_ = (s); const bool win_ = s_ < nwin; const int t_ = ua + s_ - r0; \
        if (!win_ || (t_ >= 0 && t_ < 8)) na_compute<WIN>(FK, FV, qr, o, mrun, lrun, rpb_h, win_, t_, r0, r, qc, cs, hi, vlds, lane); } while (0)
    NaFragK ka, kb; NaFragV fv;
    na_load_k(ka, Kb, NA_KROW(0), h, r32, hi);
    int s = 0;
#pragma unroll 1
    for (; s + 1 < nst; s += 2) {

        na_load_v(fv, Vb, NA_KROW(s), h, lane);
        na_load_k(kb, Kb, NA_KROW(s + 1), h, r32, hi);
        __builtin_amdgcn_sched_barrier(0);
        NA_STEP(ka, fv, s);
        __builtin_amdgcn_sched_barrier(0);

        na_load_v(fv, Vb, NA_KROW(s + 1), h, lane);
        if (s + 2 < nst) na_load_k(ka, Kb, NA_KROW(s + 2), h, r32, hi);
        __builtin_amdgcn_sched_barrier(0);
        NA_STEP(kb, fv, s + 1);
        __builtin_amdgcn_sched_barrier(0);
    }
    if (s < nst) {  na_load_v(fv, Vb, NA_KROW(s), h, lane); NA_STEP(ka, fv, s); }
#undef NA_KROW
#undef NA_STEP
    const float inv = 1.0f / lrun;
    bf16_t* orow = CAT + (size_t)(qrow0 + r32) * 1024 + 512 + h * 64;
#pragma unroll
    for (int db = 0; db < 2; ++db)
#pragma unroll
        for (int r4 = 0; r4 < 4; ++r4) {
            u32x2 w; w.x = pk2(o[db][4 * r4 + 0] * inv, o[db][4 * r4 + 1] * inv); w.y = pk2(o[db][4 * r4 + 2] * inv, o[db][4 * r4 + 3] * inv);
            *(u32x2*)(orow + db * 32 + 8 * r4 + 4 * hi) = w;
        }
}


namespace mla {
using s16x4 = __attribute__((ext_vector_type(4))) short;
constexpr int NW = 8, QBLK = 32, KVBLK = 64;
constexpr float SCALE = 0.07216878364870322f;
constexpr float THR = 8.f;
#ifndef MLA_SDEPTH
#define MLA_SDEPTH 1
#endif
constexpr int SDEPTH = MLA_SDEPTH;
constexpr int LDQ = 1536, LDKN = 1024, LDKR = 64, LDV = 1024, LDO = 1536;
constexpr int KROWB = 400;
constexpr int SHM_V = KVBLK * 128 * 2, SHM_K = KVBLK * KROWB, SHM_ATTN = 2 * SHM_V + 2 * SHM_K + NW * 64 * 4;
#define KSWZ(row, colB) ((row) * KROWB + (colB))
#define SBAR() __builtin_amdgcn_sched_barrier(0)
__device__ __forceinline__ unsigned cvtpk(float lo, float hi) { unsigned r; asm volatile("v_cvt_pk_bf16_f32 %0, %1, %2" : "=v"(r) : "v"(lo), "v"(hi)); return r; }
__device__ __forceinline__ void partialSM(f32x16& p0, f32x16& p1, float& m_reg, float& mn, float& alpha) {
  constexpr float C = SCALE * 1.4426950408889634f;
  float pmax = p0[0];
#pragma unroll
  for (int r = 1; r < 16; ++r) pmax = fmaxf(pmax, p0[r]);
#pragma unroll
  for (int r = 0; r < 16; ++r) pmax = fmaxf(pmax, p1[r]);
  { auto rr = __builtin_amdgcn_permlane32_swap(__float_as_uint(pmax), __float_as_uint(pmax), false, false);
    pmax = fmaxf(__uint_as_float(rr[0]), __uint_as_float(rr[1])); }
  if (__builtin_expect(__all(pmax - m_reg <= THR / SCALE), 1)) { mn = m_reg; alpha = 1.f; }
  else { mn = fmaxf(m_reg, pmax); alpha = __builtin_amdgcn_exp2f((m_reg - mn) * C); m_reg = mn; }
  float mnC = -mn * C;
#pragma unroll
  for (int r = 0; r < 16; ++r) p0[r] = fmaf(p0[r], C, mnC);
#pragma unroll
  for (int r = 0; r < 16; ++r) p1[r] = fmaf(p1[r], C, mnC);
#pragma unroll
  for (int r = 0; r < 16; ++r) p0[r] = __builtin_amdgcn_exp2f(p0[r]);
}
__device__ __forceinline__ void finishSM(f32x16& p0, f32x16& p1, float alpha, float& l_reg, bf16x8& pa0, bf16x8& pa1, bf16x8& pa2, bf16x8& pa3) {
#pragma unroll
  for (int r = 0; r < 16; ++r) p1[r] = __builtin_amdgcn_exp2f(p1[r]);
  float ps = 0;
#pragma unroll
  for (int r = 0; r < 16; ++r) ps += p0[r];
#pragma unroll
  for (int r = 0; r < 16; ++r) ps += p1[r];
  { auto rr = __builtin_amdgcn_permlane32_swap(__float_as_uint(ps), __float_as_uint(ps), false, false);
    ps = __uint_as_float(rr[0]) + __uint_as_float(rr[1]); }
  l_reg = l_reg * alpha + ps;
#define PK4(P, BASE, OUT) do { unsigned a0 = cvtpk(P[BASE + 0], P[BASE + 1]), a1 = cvtpk(P[BASE + 2], P[BASE + 3]);   \
    unsigned b0 = cvtpk(P[BASE + 4], P[BASE + 5]), b1 = cvtpk(P[BASE + 6], P[BASE + 7]);                              \
    auto r0 = __builtin_amdgcn_permlane32_swap(a0, b0, false, false); auto r1 = __builtin_amdgcn_permlane32_swap(a1, b1, false, false); \
    u32x4 w = {r0[0], r1[0], r0[1], r1[1]}; OUT = *reinterpret_cast<bf16x8*>(&w); } while (0)
  PK4(p0, 0, pa0); PK4(p0, 8, pa1); PK4(p1, 0, pa2); PK4(p1, 8, pa3);
#undef PK4
}
#ifndef MLA_QROPE_LDS
#define MLA_QROPE_LDS 1
#endif
constexpr int NQR = MLA_QROPE_LDS ? 8 : 12;
__device__ __forceinline__ void qkt(f32x16& p0, f32x16& p1, const char* Ks, const bf16x8* qr, const char* qrope, int r32, int hi) {
#pragma unroll
  for (int r = 0; r < 16; ++r) { p0[r] = 0.f; p1[r] = 0.f; }
  const char* kb = Ks + r32 * KROWB + hi * 16;
#pragma unroll
  for (int d0 = 0; d0 < 12; ++d0) {
    bf16x8 b0 = *reinterpret_cast<const bf16x8*>(kb + d0 * 32);
    bf16x8 b1 = *reinterpret_cast<const bf16x8*>(kb + d0 * 32 + 32 * KROWB);
    bf16x8 qv;
    if (d0 < NQR) qv = qr[d0 < NQR ? d0 : 0]; else qv = *reinterpret_cast<const bf16x8*>(qrope + (d0 - 8) * 1024);
    p0 = __builtin_amdgcn_mfma_f32_32x32x16_bf16(b0, qv, p0, 0, 0, 0);
    p1 = __builtin_amdgcn_mfma_f32_32x32x16_bf16(b1, qv, p1, 0, 0, 0); }
}
__device__ __forceinline__ int v_st(int k, int c) { const int kk = (k & ~0xC) | ((k & 4) << 1) | ((k & 8) >> 1); return ((kk >> 3) * 4 + (c >> 5)) * 512 + ((kk & 7) * 32 + (c & 31)) * 2; }
__device__ __forceinline__ int v_rd_base(int lane) { return ((lane & 3) << 3) | (((lane >> 2) & 3) << 6) | (((lane >> 4) & 1) << 5) | (((lane >> 5) & 1) << 8); }
constexpr int v_rd_off(int d0, int ks, int half) { return d0 * 512 + ks * 4096 + half * 2048; }
template <int OFF> __device__ __forceinline__ s16x4 tr_read(int vb) {
  s16x4 r; asm volatile("ds_read_b64_tr_b16 %0, %1 offset:%2" : "=&v"(r) : "v"(vb), "i"(OFF) : "memory"); return r;
}
template <int D0> __device__ __forceinline__ void pv_one(f32x16& od, int vb, bf16x8 pa0, bf16x8 pa1, bf16x8 pa2, bf16x8 pa3) {
  const s16x4 l0 = tr_read<v_rd_off(D0, 0, 0)>(vb), h0 = tr_read<v_rd_off(D0, 0, 1)>(vb), l1 = tr_read<v_rd_off(D0, 1, 0)>(vb), h1 = tr_read<v_rd_off(D0, 1, 1)>(vb);
  const s16x4 l2 = tr_read<v_rd_off(D0, 2, 0)>(vb), h2 = tr_read<v_rd_off(D0, 2, 1)>(vb), l3 = tr_read<v_rd_off(D0, 3, 0)>(vb), h3 = tr_read<v_rd_off(D0, 3, 1)>(vb);
  asm volatile("s_waitcnt lgkmcnt(0)" ::: "memory"); SBAR();
#define PK(L, H) (bf16x8){L[0], L[1], L[2], L[3], H[0], H[1], H[2], H[3]}
  od = __builtin_amdgcn_mfma_f32_32x32x16_bf16(pa0, PK(l0, h0), od, 0, 0, 0);
  od = __builtin_amdgcn_mfma_f32_32x32x16_bf16(pa1, PK(l1, h1), od, 0, 0, 0);
  od = __builtin_amdgcn_mfma_f32_32x32x16_bf16(pa2, PK(l2, h2), od, 0, 0, 0);
  od = __builtin_amdgcn_mfma_f32_32x32x16_bf16(pa3, PK(l3, h3), od, 0, 0, 0);
#undef PK
}
__device__ __forceinline__ void pv_d0(f32x16* o, int vb, bf16x8 pa0, bf16x8 pa1, bf16x8 pa2, bf16x8 pa3) {
  pv_one<0>(o[0], vb, pa0, pa1, pa2, pa3); pv_one<1>(o[1], vb, pa0, pa1, pa2, pa3); pv_one<2>(o[2], vb, pa0, pa1, pa2, pa3); pv_one<3>(o[3], vb, pa0, pa1, pa2, pa3);
}
__device__ __forceinline__ void attn_body(const bf16_t* Qb, const bf16_t* __restrict__ KNh, const bf16_t* __restrict__ KRb, const bf16_t* __restrict__ Vh, bf16_t* Ob, int seq, char* lds) {
  const int tid = threadIdx.x, wid = tid >> 6, lane = tid & 63, r32 = lane & 31, hi = lane >> 5;
  char* V_lds = lds; char* K_lds = lds + 2 * SHM_V;
  float* ws = (float*)(lds + 2 * SHM_V + 2 * SHM_K) + wid * 64; float* li_l = ws; float* al_l = ws + 32;
  float m_reg = -1e30f, l_reg = 0; f32x16 o[4]; bf16x8 qr[NQR];
#pragma unroll
  for (int d = 0; d < 4; ++d)
#pragma unroll
    for (int r = 0; r < 16; ++r) o[d][r] = 0.f;
  const bf16_t* Qw = Qb + (long)(wid * QBLK + r32) * LDQ + hi * 8;
  char* qrope = lds + 2 * SHM_V + 2 * SHM_K + NW * 64 * 4 + wid * 4096 + hi * 512 + r32 * 16;
#pragma unroll
  for (int d0 = 0; d0 < 12; ++d0) { const bf16x8 qv = *reinterpret_cast<const bf16x8*>(Qw + d0 * 16);
    if (d0 < NQR) qr[d0 < NQR ? d0 : 0] = qv; else *reinterpret_cast<bf16x8*>(qrope + (d0 - 8) * 1024) = qv; }
  const int sr = tid >> 4, sc = (tid & 15) * 8, vst0 = v_st(sr, sc), vst1 = v_st(32 + sr, sc);
  const int rr_ = tid >> 3, rc = (tid & 7) * 8;
  const int vb0 = (int)(uintptr_t)V_lds + v_rd_base(lane);
  struct { bf16x8 vs0, vs1, ks0, ks1, kr0; } sr_[SDEPTH];
#define SLOAD(i, k0) do { sr_[i].vs0 = *(const bf16x8*)(&Vh[(long)((k0) + sr) * LDV + sc]); sr_[i].vs1 = *(const bf16x8*)(&Vh[(long)((k0) + 32 + sr) * LDV + sc]); \
    sr_[i].ks0 = *(const bf16x8*)(&KNh[(long)((k0) + sr) * LDKN + sc]); sr_[i].ks1 = *(const bf16x8*)(&KNh[(long)((k0) + 32 + sr) * LDKN + sc]); \
    sr_[i].kr0 = *(const bf16x8*)(&KRb[(long)((k0) + rr_) * LDKR + rc]); } while (0)
#define SWRITE(b, i) do { *(bf16x8*)(V_lds + (b) * SHM_V + vst0) = sr_[i].vs0;          \
    *(bf16x8*)(V_lds + (b) * SHM_V + vst1) = sr_[i].vs1; const int kc = sc * 2;               \
    *(bf16x8*)(K_lds + (b) * SHM_K + KSWZ(sr, kc)) = sr_[i].ks0;                       \
    *(bf16x8*)(K_lds + (b) * SHM_K + KSWZ(32 + sr, kc)) = sr_[i].ks1;                  \
    *(bf16x8*)(K_lds + (b) * SHM_K + KSWZ(rr_, 256 + rc * 2)) = sr_[i].kr0; } while (0)
#define SWAIT() do { if constexpr (SDEPTH == 2) asm volatile("s_waitcnt vmcnt(5)" ::: "memory"); else asm volatile("s_waitcnt vmcnt(0)" ::: "memory"); } while (0)
#define RESC(a) do { if (__any((a) < 1.f)) { if (hi == 0) al_l[r32] = (a); asm volatile("s_waitcnt lgkmcnt(0)" ::: "memory"); \
    _Pragma("unroll") for (int d = 0; d < 4; ++d) _Pragma("unroll") for (int r = 0; r < 16; ++r) o[d][r] *= al_l[crow(r, hi)]; } } while (0)
  f32x16 pA0, pA1, pB0, pB1; float mnA, mnB, alA, alB; bf16x8 pa0, pa1, pa2, pa3; const int NT = seq / KVBLK;
  constexpr int SE = 0, SO = SDEPTH - 1;
  SLOAD(SE, 0); asm volatile("s_waitcnt vmcnt(0)" ::: "memory"); SWRITE(0, SE); __syncthreads();
  qkt(pA0, pA1, K_lds, qr, qrope, r32, hi); partialSM(pA0, pA1, m_reg, mnA, alA);
  SLOAD(SO, KVBLK); if constexpr (SDEPTH == 2) { if (2 < NT) SLOAD(SE, 2 * KVBLK); }
  SWAIT(); SWRITE(1, SO); __syncthreads();
  for (int j = 1; j + 1 < NT; j += 2) {
    SBAR(); qkt(pB0, pB1, K_lds + SHM_K, qr, qrope, r32, hi);
    finishSM(pA0, pA1, alA, l_reg, pa0, pa1, pa2, pa3); SBAR();
    SLOAD(SO, (j + SDEPTH) * KVBLK); SBAR();
    pv_d0(o, vb0, pa0, pa1, pa2, pa3); partialSM(pB0, pB1, m_reg, mnB, alB);
    __syncthreads(); SWAIT(); SWRITE(0, SE);
    RESC(alB); __syncthreads();
    SBAR(); qkt(pA0, pA1, K_lds, qr, qrope, r32, hi);
    finishSM(pB0, pB1, alB, l_reg, pa0, pa1, pa2, pa3); SBAR();
    if (SDEPTH == 1 || j + 3 < NT) SLOAD(SE, (j + 1 + SDEPTH) * KVBLK); SBAR();
    pv_d0(o, vb0 + (int)SHM_V, pa0, pa1, pa2, pa3); partialSM(pA0, pA1, m_reg, mnA, alA);
    __syncthreads(); SWAIT(); SWRITE(1, SO);
    RESC(alA); __syncthreads();
  }
  SBAR(); qkt(pB0, pB1, K_lds + SHM_K, qr, qrope, r32, hi);
  finishSM(pA0, pA1, alA, l_reg, pa0, pa1, pa2, pa3); SBAR();
  pv_d0(o, vb0, pa0, pa1, pa2, pa3); partialSM(pB0, pB1, m_reg, mnB, alB);
  __syncthreads(); RESC(alB);
  finishSM(pB0, pB1, alB, l_reg, pa0, pa1, pa2, pa3); SBAR();
  pv_d0(o, vb0 + (int)SHM_V, pa0, pa1, pa2, pa3);
  if (hi == 0) li_l[r32] = l_reg; asm volatile("s_waitcnt lgkmcnt(0)" ::: "memory");
  float rli[16];
#pragma unroll
  for (int r = 0; r < 16; ++r) rli[r] = __builtin_amdgcn_rcpf(li_l[crow(r, hi)]);
  bf16_t* Ow = Ob + (long)(wid * QBLK) * LDO;
#pragma unroll
  for (int r = 0; r < 16; ++r) { const int orow = crow(r, hi);
#pragma unroll
    for (int d0 = 0; d0 < 4; ++d0) Ow[(long)orow * LDO + d0 * 32 + r32] = (bf16_t)f2bf(o[d0][r] * rli[r]); }
  __syncthreads();
#undef SLOAD
#undef SWRITE
#undef SWAIT
#undef RESC
}
#undef KSWZ
#undef SBAR
}


typedef unsigned v4u_xb __attribute__((ext_vector_type(4)));
#define XB_TMO      128
#define XB_XCNT(j)  (256  + 64 * (j))
#define XB_XSUB(j)  (1280 + 64 * (j))
#define XB_XGEN(j)  (2304 + 64 * (j))
#define XB_TOP      3328
#define XB_TOPGEN   3392
#define XCD_BAR_WORDS 3456
#define XB_SPIN_CAP (1u << 18)

__device__ __forceinline__ unsigned xb_ld(unsigned* p)              { return __hip_atomic_load(p, __ATOMIC_RELAXED, __HIP_MEMORY_SCOPE_AGENT); }
__device__ __forceinline__ unsigned xb_add(unsigned* p, unsigned v) { return __hip_atomic_fetch_add(p, v, __ATOMIC_RELAXED, __HIP_MEMORY_SCOPE_AGENT); }
__device__ __forceinline__ unsigned xb_xcc_id() { return (unsigned)__builtin_amdgcn_s_getreg((3 << 11) | 20) & 0xFu; }
#define XB_SPIN(cond, bar) do { unsigned _sp = 0; while (cond) { __builtin_amdgcn_s_sleep(1); \
    if ((++_sp & 255u) == 0u) { if (xb_ld(&(bar)[XB_TMO])) break; if (_sp > XB_SPIN_CAP) { atomicAdd(&(bar)[XB_TMO], 1u); break; } } } } while (0)

struct XcdBarrier {
    unsigned* bar; unsigned x;
    volatile LAS unsigned* st;
};

__device__ __forceinline__ XcdBarrier xcd_barrier_post(unsigned* bar, volatile LAS unsigned* st) {
    XcdBarrier b; b.bar = bar; b.x = xb_xcc_id(); b.st = st;
    if (threadIdx.x == 0) (void)xb_add(&bar[XB_XCNT(b.x)], 1u);
    return b;
}
__device__ __forceinline__ void xcd_barrier_complete(unsigned* bar, unsigned x, unsigned& nloc, unsigned& nx) {
    const unsigned G = gridDim.x * gridDim.y * gridDim.z;
    unsigned sum, cnt, mine, sp = 0u;
    for (;;) {
        sum = 0u; cnt = 0u; mine = 0u;
#pragma unroll
        for (unsigned j = 0; j < 16; ++j) { const unsigned c = xb_ld(&bar[XB_XCNT(j)]); sum += c; cnt += (c > 0u) ? 1u : 0u; mine = (j == x) ? c : mine; }
        if (sum == G) break;
        __builtin_amdgcn_s_sleep(1);
        if ((++sp & 255u) == 0u) { if (xb_ld(&bar[XB_TMO])) break; if (sp > XB_SPIN_CAP) { atomicAdd(&bar[XB_TMO], 1u); break; } }
    }
    nloc = mine > 0u ? mine : 1u; nx = cnt > 0u ? cnt : 1u;
}

__device__ __forceinline__ void xcd_barrier(const XcdBarrier& b) {
    asm volatile("s_waitcnt vmcnt(0)" ::: "memory");
    __syncthreads();
    if (threadIdx.x == 0) {
        unsigned* bar = b.bar;
        __builtin_amdgcn_s_waitcnt(0);
        unsigned nloc = b.st[0], nx = b.st[1];
        if (nloc == 0u) { xcd_barrier_complete(bar, b.x, nloc, nx); b.st[0] = nloc; b.st[1] = nx; }
        const unsigned old = xb_add(&bar[XB_XSUB(b.x)], 1u);
        const unsigned gen = old / nloc;
        if (old + 1u == (gen + 1u) * nloc) {
            __builtin_amdgcn_fence(__ATOMIC_RELEASE, "agent");
            asm volatile("s_waitcnt vmcnt(0)" ::: "memory");
            const unsigned og = xb_add(&bar[XB_TOP], 1u);
            const unsigned tg = og / nx;
            if (og + 1u == (tg + 1u) * nx) xb_add(&bar[XB_TOPGEN], 1u);
            else XB_SPIN(xb_ld(&bar[XB_TOPGEN]) == tg, bar);
            __builtin_amdgcn_fence(__ATOMIC_ACQUIRE, "agent");
            xb_add(&bar[XB_XGEN(b.x)], 1u);
            asm volatile("s_waitcnt vmcnt(0)" ::: "memory");
        } else {
            XB_SPIN(xb_ld(&bar[XB_XGEN(b.x)]) == gen, bar);
            __builtin_amdgcn_fence(__ATOMIC_ACQUIRE, "agent");
            asm volatile("s_waitcnt vmcnt(0)" ::: "memory");
        }
    }
    __syncthreads();
}

__device__ __forceinline__ void grid_bar(unsigned* ctr, unsigned target) {
    asm volatile("s_waitcnt vmcnt(0)" ::: "memory");
    __syncthreads();
    if (threadIdx.x == 0) {
        __builtin_amdgcn_fence(__ATOMIC_RELEASE, "agent");
        asm volatile("s_waitcnt vmcnt(0)" ::: "memory");
        __hip_atomic_fetch_add(ctr, 1u, __ATOMIC_RELAXED, __HIP_MEMORY_SCOPE_AGENT);
        while (__hip_atomic_load(ctr, __ATOMIC_RELAXED, __HIP_MEMORY_SCOPE_AGENT) < target) __builtin_amdgcn_s_sleep(2);
        __builtin_amdgcn_fence(__ATOMIC_ACQUIRE, "agent");
        asm volatile("s_waitcnt vmcnt(0)" ::: "memory");
    }
    __syncthreads();
}
__device__ __forceinline__ int fresh_lane() { int t = threadIdx.x; asm volatile("" : "+v"(t)); return t & 63; }
struct Args { const float* in[21]; float* out; unsigned char* ws; int ph_lo, ph_hi; };
constexpr int NPHASE = 24;

__global__ void __launch_bounds__(NWAVES * 64, 2) fwd_kernel(Args args) {
    extern __shared__ __attribute__((aligned(16))) unsigned char lds_raw[];
    cg::grid_group grid = cg::this_grid();
    LAS unsigned char* lds = (LAS unsigned char*)lds_raw;
    const int tid = threadIdx.x, wave = __builtin_amdgcn_readfirstlane(tid >> 6);
#define lane fresh_lane()
    const int G = gridDim.x, bx = blockIdx.x;
    const int vcu = (G % 8 == 0) ? (bx % 8) * (G / 8) + bx / 8 : bx;
    const int gw = vcu * NWAVES + wave, NGW = G * NWAVES;
    unsigned char* ws = args.ws;
    float* cosT = (float*)(ws + WS_ROPE); float* sinT = cosT + 1024;
    float* mod = (float*)(ws + WS_MOD); const float* mod0 = mod; const float* mod1 = mod + (size_t)9 * 9216;
    float* X = (float*)(ws + WS_X);
    bf16_t* H = (bf16_t*)(ws + WS_H);
    bf16_t* ACT = (bf16_t*)(ws + WS_A);
    const int lo = args.ph_lo, hi = args.ph_hi;
    volatile LAS unsigned* xb_st = (volatile LAS unsigned*)(lds + 131072 + 64);
    if (tid < 2) xb_st[tid] = 0u;
    __syncthreads();
    if (hi - lo > 1) (void)xcd_barrier_post((unsigned*)(ws + 8192), xb_st);
    if (hi - lo > 1) grid.sync();
#define IN(k) (lo <= (k) && (k) < hi)
#define SEAM(k) do { if (IN(k) && IN((k) + 1)) { XcdBarrier xb_; xb_.bar = (unsigned*)(ws + 8192); xb_.x = xb_xcc_id(); xb_.st = (volatile LAS unsigned*)(lds + 131072 + 64); xcd_barrier(xb_); } } while (0)
#define GEMM(EpiT, SchedT, g, S, E) pg8::gemm_phase<EpiT, SchedT, true, true>(lds, g, S, E)
#define GEMM_SEQ(EpiT, SchedT, g, S, E) pg8::gemm_phase<EpiT, SchedT, false, true>(lds, g, S, E)

    if (IN(0)) {
        for (int i = gw * 64 + lane; i < 1024; i += NGW * 64) { const int pos = i >> 4, j = i & 15; const float inv = powf(10000.0f, -(float)(2 * j) / 32.0f); const float a = (float)pos * inv;
            cosT[i] = cosf(a); sinT[i] = sinf(a); }
        mod_gemv(args.in[1], args.in[3], args.in[4], args.in[5], mod, (LAS float*)lds, tid, bx, G);
        __syncthreads();
        LAS float* scr = (LAS float*)(lds + wave * 16384);
        conv_ffn(args.in[7], args.in[8], args.in[9], 0, ws, W0_WGU0, W0_WD0, W0_WGU1, W0_WD1, scr, gw, NGW, lane);
        conv_w(args.in[10] + 512, 2048, 1024, 1536, MapPlain{(bf16_t*)(ws + W0_WAB) + (size_t)1024 * 1024, 1024}, scr, gw, NGW, lane, 300);
        conv_w(args.in[12], 1024, 1024, 1024, MapPlain{(bf16_t*)(ws + W0_WOUT), 1024}, scr, gw, NGW, lane, 1100);
        __syncthreads();
        { LAS float* tab = (LAS float*)lds;
          if (tid < 256) { const int i = tid & 127; const float a = (float)i * (2.0f / 128.0f); tab[tid] = (tid < 128) ? cospif(a) : sinpif(a); }
          __syncthreads();
          fold_pq(args.in[10], (bf16_t*)(ws + W0_WAB), tab, gw, NGW, lane);
          __syncthreads(); }
        gen_dft((bf16_t*)(ws + WS_DFTL), 4096, 12, 1.0f / 64.0f, 2048, 1.0f, (long)gw * 64 + lane, (long)NGW * 64);
        gen_dft((bf16_t*)(ws + WS_DFTC), 256, 8, 1.0f / 16.0f, 256, -1.0f, (long)gw * 64 + lane, (long)NGW * 64);
    }
    SEAM(0);
    if (IN(1)) norm_pass(nullptr, args.in[0], args.in[2], args.in[6] + 0 * DM, mod0, 0, 1, H, false, gw, NGW, lane, X);
    SEAM(1);
    if (IN(2)) { pg8::Gemm g{H, (const bf16_t*)(ws + W0_WGU0), MTOT, 2 * DFF, DM}; pg8::StaticOrder S; S.init(MTOT, 2 * DFF, G, bx); EpiSwiGLU E{ACT}; GEMM(EpiSwiGLU, pg8::StaticOrder, g, S, E); }
    SEAM(2);
    if (IN(3)) { pg8::Gemm g{ACT, (const bf16_t*)(ws + W0_WD0), MTOT, DM, DFF}; { pg8::StaticOrder S; S.init(TAIL_ROW0, DM, G, bx); EpiResidIn E{args.in[0], args.in[2], X, mod0, 2, 0.5f}; GEMM_SEQ(EpiResidIn, pg8::StaticOrder, g, S, E); } { TailOrder<4> S; S.init(DFF, G, bx); EpiPartial E{args.out, mod0, 2, 0.5f}; GEMM(EpiPartial, TailOrder<4>, g, S, E); } }
    SEAM(3);
    if (IN(4)) norm_pass(X, args.in[0], args.in[2], args.in[6] + 1 * DM, mod0, 3, 4, H, false, gw, NGW, lane, X, args.out, 4);
    SEAM(4);
    if (IN(5)) {
        const bf16_t* Wab = (const bf16_t*)(ws + W0_WAB);
        { pg8::Gemm g{Wab, H, 1024, MTOT, DM}; pg8::StaticOrder S; S.init(1024, MTOT, G, bx); EpiPQT E{(bf16_t*)(ws + A_PQL), (bf16_t*)(ws + A_PQC)}; GEMM(EpiPQT, pg8::StaticOrder, g, S, E); }
        { pg8::Gemm g{H, Wab + (size_t)1024 * 1024, MTOT, 1536, DM}; RotOrder S; S.init(MTOT, 1536, G, bx, 224);
          pg8::EpiBf16<0> E{(bf16_t*)(ws + A_QN), 512, nullptr, 512, (A_KNA - A_QN) / 2, 1.0f}; GEMM(pg8::EpiBf16<0>, RotOrder, g, S, E); }
    }
    SEAM(5);
    if (IN(6)) {
        { pg8::Gemm g{(const bf16_t*)(ws + WS_DFTL), (const bf16_t*)(ws + A_PQL), 2048, 4096, 8192}; DftPieceOrder S; S.init(G, bx); EpiEF E{args.out}; GEMM(EpiEF, DftPieceOrder, g, S, E); }
        { pg8::Gemm g{(const bf16_t*)(ws + WS_DFTC), (const bf16_t*)(ws + A_PQC), 256, 4096, 512}; RotOrder S; S.init(256, 4096, G, bx, 128); EpiDFT E{H, SEQ}; GEMM(EpiDFT, RotOrder, g, S, E); }
        __syncthreads();
        LAS float* rpb = (LAS float*)(lds + 65536);
        for (int i = tid; i < 8 * 15 * 128; i += 512) { const int j = (i & 127) - 48; rpb[i] = (j >= 0 && j < 31) ? args.in[11][(i >> 7) * 31 + j] * LOG2E : 0.f; }
        __syncthreads();
        const bf16_t* QN = (const bf16_t*)(ws + A_QN); const bf16_t* KNA = (const bf16_t*)(ws + A_KNA); const bf16_t* VT = (const bf16_t*)(ws + A_VT);
        for (int u0 = vcu * 8; u0 < 8192; u0 += G * 8) {
            const int u = u0 + wave, qh = u & 1, r = (u >> 1) & 63, h = (u >> 7) & 7, b = u >> 10;
            na_unit<true>(QN, KNA, VT, H, rpb + h * 1920, b, h, b * TPB + r * 64 + qh * 32, r, qh * 32, lane, (LAS char*)(lds + wave * 8192));
        }
        for (int u0 = bx * 8; u0 < 512; u0 += G * 8) {
            const int u = u0 + wave, qb = u & 7, h = (u >> 3) & 7, b = u >> 6;
            na_unit<false>(QN, KNA, VT, H, rpb, b, h, b * TPB + SEQ + qb * 32, 0, 0, lane, (LAS char*)(lds + wave * 8192));
        }
        __syncthreads();
        if (hi - lo > 1) { XcdBarrier xb_; xb_.bar = (unsigned*)(ws + 8192); xb_.x = xb_xcc_id(); xb_.st = (volatile LAS unsigned*)(lds + 131072 + 64); xcd_barrier(xb_); }
        dft_combine(args.out, H, (long)gw * 64 + lane, (long)NGW * 64);
        dft_nyquist((const bf16_t*)(ws + A_PQL), H, gw, NGW, lane);
    }
    SEAM(6);
    if (IN(7)) { pg8::Gemm g{H, (const bf16_t*)(ws + W0_WOUT), MTOT, DM, DM}; { pg8::StaticOrder S; S.init(TAIL_ROW0, DM, G, bx); EpiResid E{X, mod0, 5, 1.0f}; GEMM_SEQ(EpiResid, pg8::StaticOrder, g, S, E); } { TailOrder<4> S; S.init(DM, G, bx); EpiPartial E{args.out, mod0, 5, 1.0f}; GEMM(EpiPartial, TailOrder<4>, g, S, E); } }
    SEAM(7);
    if (IN(8)) {
        norm_pass(X, args.in[0], args.in[2], args.in[6] + 2 * DM, mod0, 6, 7, H, false, gw, NGW, lane, X, args.out, 4);
        LAS float* scr = (LAS float*)(lds + wave * 16384);
        conv_ffn(args.in[7], args.in[8], args.in[9], 1, ws, W1_WGU0, W1_WD0, W1_WGU1, W1_WD1, scr, gw, NGW, lane);
        conv_w(args.in[13], 576, 1024, 576, MapPlain{(bf16_t*)(ws + W1_WIN), 1024}, scr, gw, NGW, lane, 100);
        conv_w(args.in[16], 1536, 384, 1536, MapPlain{(bf16_t*)(ws + W1_WUQ), 384}, scr, gw, NGW, lane, 500);
        conv_w(args.in[17], 1024, 128, 1024, MapPlain{(bf16_t*)(ws + W1_WUKV), 256}, scr, gw, NGW, lane, 900);
        conv_w(args.in[18], 1024, 128, 1024, MapPlain{(bf16_t*)(ws + W1_WUKV) + (size_t)1024 * 256, 256}, scr, gw, NGW, lane, 1000);
        conv_w(args.in[19], 1024, 1024, 1024, MapWo{(bf16_t*)(ws + W1_WO)}, scr, gw, NGW, lane, 1200);
        const long gt = (long)gw * 64 + lane, NT_ = (long)NGW * 64; const u32x4 z4 = {0u, 0u, 0u, 0u};
        for (long i = gt; i < 192 * 128; i += NT_) *(u32x4*)((bf16_t*)(ws + W1_WIN) + (size_t)576 * 1024 + i * 8) = z4;
        for (long i = gt; i < 2048 * 16; i += NT_) *(u32x4*)((bf16_t*)(ws + W1_WUKV) + (i >> 4) * 256 + 128 + (i & 15) * 8) = z4;
        for (long i = gt; i < 1024 * 64; i += NT_) *(u32x4*)((bf16_t*)(ws + W1_WO) + (i >> 6) * 1536 + ((i >> 3) & 7) * 192 + 128 + (i & 7) * 8) = z4;
    }
    SEAM(8);
    if (IN(9)) { pg8::Gemm g{H, (const bf16_t*)(ws + W0_WGU1), MTOT, 2 * DFF, DM}; pg8::StaticOrder S; S.init(MTOT, 2 * DFF, G, bx); EpiSwiGLU E{ACT}; GEMM(EpiSwiGLU, pg8::StaticOrder, g, S, E); }
    SEAM(9);
    if (IN(10)) { pg8::Gemm g{ACT, (const bf16_t*)(ws + W0_WD1), MTOT, DM, DFF}; { pg8::StaticOrder S; S.init(TAIL_ROW0, DM, G, bx); EpiResid E{X, mod0, 8, 0.5f}; GEMM_SEQ(EpiResid, pg8::StaticOrder, g, S, E); } { TailOrder<4> S; S.init(DFF, G, bx); EpiPartial E{args.out, mod0, 8, 0.5f}; GEMM(EpiPartial, TailOrder<4>, g, S, E); } }
    SEAM(10);
    if (IN(11)) norm_pass(X, args.in[0], args.in[2], args.in[6] + 3 * DM, mod1, 0, 1, H, false, gw, NGW, lane, X, args.out, 4);
    SEAM(11);
    if (IN(12)) { pg8::Gemm g{H, (const bf16_t*)(ws + W1_WGU0), MTOT, 2 * DFF, DM}; pg8::StaticOrder S; S.init(MTOT, 2 * DFF, G, bx); EpiSwiGLU E{ACT}; GEMM(EpiSwiGLU, pg8::StaticOrder, g, S, E); }
    SEAM(12);
    if (IN(13)) { pg8::Gemm g{ACT, (const bf16_t*)(ws + W1_WD0), MTOT, DM, DFF}; { pg8::StaticOrder S; S.init(TAIL_ROW0, DM, G, bx); EpiResid E{X, mod1, 2, 0.5f}; GEMM_SEQ(EpiResid, pg8::StaticOrder, g, S, E); } { TailOrder<4> S; S.init(DFF, G, bx); EpiPartial E{args.out, mod1, 2, 0.5f}; GEMM(EpiPartial, TailOrder<4>, g, S, E); } }
    SEAM(13);
    if (IN(14)) norm_pass(X, args.in[0], args.in[2], args.in[6] + 4 * DM, mod1, 3, 4, H, false, gw, NGW, lane, X, args.out, 4);
    SEAM(14);
    if (IN(15)) { pg8::Gemm g{H, (const bf16_t*)(ws + W1_WIN), MTOT, 768, DM}; pg8::StaticOrder S; S.init(MTOT, 768, G, bx); EpiZ E{(float*)(ws + A_Z)}; GEMM(EpiZ, pg8::StaticOrder, g, S, E); }
    SEAM(15);
    if (IN(16)) mla_norm_pass((const float*)(ws + A_Z), args.in[14], args.in[15], cosT, sinT, (bf16_t*)(ws + A_CQ), (bf16_t*)(ws + A_CKV), (bf16_t*)(ws + A_KR), gw, NGW, lane);
    SEAM(16);
    if (IN(17)) {
        { int k384 = 384; asm volatile("" : "+s"(k384)); pg8::Gemm g{(const bf16_t*)(ws + A_CQ), (const bf16_t*)(ws + W1_WUQ), MTOT, 1536, k384}; LatentOrder S; S.init(1536, G, bx); EpiQRope E{(bf16_t*)(ws + A_QB), cosT, sinT}; GEMM(EpiQRope, LatentOrder, g, S, E); }
        { int k256 = 256; asm volatile("" : "+s"(k256)); pg8::Gemm g{(const bf16_t*)(ws + A_CKV), (const bf16_t*)(ws + W1_WUKV), MTOT, 2048, k256}; pg8::StaticOrder S; S.init(MTOT, 2048, G, bx);
          pg8::EpiBf16<0> E{H, 1024, nullptr, 1024, (size_t)((ws + WS_VB) - (ws + WS_H)) / 2, 1.0f}; GEMM(pg8::EpiBf16<0>, pg8::StaticOrder, g, S, E); }
    }
    SEAM(17);
    if (IN(18)) {
        bf16_t* QB = (bf16_t*)(ws + A_QB); const bf16_t* KN = H; const bf16_t* KR = (const bf16_t*)(ws + A_KR); const bf16_t* VB = (const bf16_t*)(ws + WS_VB);
        const int per = (1024 + G - 1) / G;
        for (int i = 0; i < per; ++i) {
            const int u = vcu * per + i; if (u >= 1024) break;
            const int qb = u & 15, h = (u >> 4) & 7, b = u >> 7;
            const size_t qrow = (size_t)b * TPB + qb * 256, krow = (size_t)b * TPB;
            mla::attn_body(QB + qrow * 1536 + h * 192, KN + krow * 1024 + h * 128, KR + krow * 64, VB + krow * 1024 + h * 128, QB + qrow * 1536 + h * 192, TPB, (char*)lds_raw);
        }
    }
    SEAM(18);
    if (IN(19)) { pg8::Gemm g{(const bf16_t*)(ws + A_QB), (const bf16_t*)(ws + W1_WO), MTOT, DM, 1536}; LatentOrder S; S.init(DM, G, bx); EpiResid E{X, mod1, 5, 1.0f}; GEMM_SEQ(EpiResid, LatentOrder, g, S, E); }
    SEAM(19);
    if (IN(20)) norm_pass(X, args.in[0], args.in[2], args.in[6] + 5 * DM, mod1, 6, 7, H, true, gw, NGW, lane);
    SEAM(20);
    if (IN(21)) { pg8::Gemm g{H, (const bf16_t*)(ws + W1_WGU1), MTOT, 2 * DFF, DM}; LatentOrder S; S.init(2 * DFF, G, bx); EpiSwiGLU E{ACT}; GEMM(EpiSwiGLU, LatentOrder, g, S, E); }
    SEAM(21);
    if (IN(22)) { pg8::Gemm g{ACT, (const bf16_t*)(ws + W1_WD1), MTOT, DM, DFF}; LatentOrder S; S.init(DM, G, bx); EpiResid E{X, mod1, 8, 0.5f}; GEMM_SEQ(EpiResid, LatentOrder, g, S, E); }
    SEAM(22);
    if (IN(23)) final_norm(X, args.in[20], args.out, gw, NGW, lane);
#undef IN
#undef SEAM
#undef GEMM
#undef GEMM_SEQ
#undef lane
}

#ifndef N_LAUNCH_MODE
#define N_LAUNCH_MODE 1
#endif
extern "C" void kernel_launch(void* const* d_in, const int* in_sizes, int n_in, void* d_out, int out_size, void* d_ws, size_t ws_size, hipStream_t stream) {
    static int grid = 0;
    if (grid == 0) {
        if (n_in != 21 || ws_size < WS_END) { fprintf(stderr, "kernel_launch: n_in %d ws %zu (need %zu)\n", n_in, ws_size, (size_t)WS_END); grid = -1; return; }
        int dev = 0, cus = 0, per_cu = 0;
        hipGetDevice(&dev);
        hipDeviceGetAttribute(&cus, hipDeviceAttributeMultiprocessorCount, dev);
        hipFuncSetAttribute((const void*)fwd_kernel, hipFuncAttributeMaxDynamicSharedMemorySize, LDS_BYTES);
        hipOccupancyMaxActiveBlocksPerMultiprocessor(&per_cu, (const void*)fwd_kernel, NWAVES * 64, LDS_BYTES);
        if (per_cu < 1) per_cu = 1;
        (void)hipGetLastError();
        grid = cus * per_cu;
    }
    if (grid < 0) return;
    Args a{};
    for (int i = 0; i < 21; ++i) a.in[i] = (const float*)d_in[i];
    a.out = (float*)d_out; a.ws = (unsigned char*)d_ws;
    (void)hipMemsetAsync(d_ws, 0, 32768, stream);
#if N_LAUNCH_MODE == 1
    a.ph_lo = 0; a.ph_hi = NPHASE;
    void* kargs[] = {&a};
    hipError_t e = hipLaunchCooperativeKernel((const void*)fwd_kernel, dim3(grid), dim3(NWAVES * 64), kargs, LDS_BYTES, stream);
    if (e != hipSuccess) fprintf(stderr, "cooperative launch failed: %s (grid %d)\n", hipGetErrorString(e), grid);
#else
    for (int p = 0; p < NPHASE; ++p) { a.ph_lo = p; a.ph_hi = p + 1; hipLaunchKernelGGL(fwd_kernel, dim3(grid), dim3(NWAVES * 64), LDS_BYTES, stream, a); }
#endif
}
```

```cpp
#include <hip/hip_runtime.h>
#include <hip/hip_cooperative_groups.h>
#include <cstdio>
#include <cstdint>
namespace cg = cooperative_groups;
namespace pg8 {
#define PG8_LAS __attribute__((address_space(3)))
typedef unsigned short bf16_t;
typedef short bf16x8 __attribute__((ext_vector_type(8)));
typedef float f32x4 __attribute__((ext_vector_type(4)));
typedef unsigned u32x4 __attribute__((ext_vector_type(4)));
constexpr int BM = 256, BK = 64, HALF = 128, HTB = HALF * BK * 2  , STAGE_BYTES = 8 * HTB, NXCD = 8, WGM = 8;

__host__ __device__ __forceinline__ int lds_byte(int r, int c) { const int st = (r >> 4) * 2 + (c >> 5), rr = r & 15, cc = c & 31, ob = rr * 64 + cc * 2; return st * 1024 + (ob ^ (((ob >> 9) & 1) << 5)); }
__host__ __device__ __forceinline__ void stage_rc(int b, int& R, int& C) { const int st = b / 1024, sb = b % 1024, swz = sb ^ (((sb >> 9) & 1) << 5); R = (st >> 1) * 16 + swz / 64; C = (st & 1) * 32 + (swz % 64) / 2; }
__host__ __device__ __forceinline__ int perm32(int rho) { const int n = rho >> 4, i = rho & 15; return 8 * (i >> 2) + 4 * n + (i & 3); }

struct Unit { int pm, pn; };
struct Gemm { const bf16_t* A; const bf16_t* Bt; int M, N, K; };

struct StaticOrder {
    int nM, nN, nwg, G, c;
    __host__ __device__ __forceinline__ void init(int M, int N, int G_, int c_) { nM = M / BM; nN = N / BM; nwg = nM * nN; G = G_; c = c_; }
    __host__ __device__ __forceinline__ bool next(int i, Unit& u) const {
        const long L = (long)i * G + c; if (L >= nwg) return false;
        int wgid = (int)L; { const int q = nwg / NXCD, r = nwg % NXCD, xcd = wgid % NXCD, off = wgid / NXCD; wgid = (xcd < r ? xcd * (q + 1) : r * (q + 1) + (xcd - r) * q) + off; }
        const int nig = WGM * nN, gid = wgid / nig, fm = gid * WGM, gsz = (nM - fm) < WGM ? (nM - fm) : WGM;
        u.pm = fm + ((wgid % nig) % gsz); u.pn = (wgid % nig) / gsz; return true;
    }
    __device__ __forceinline__ void a_ready(const Unit&) const {}
    __device__ __forceinline__ void done(const Unit&) const {}
    __device__ __forceinline__ int kt0(const Unit&) const { return 0; }
    __device__ __forceinline__ int nkt(const Unit&, int full) const { return full; }
};

__device__ __forceinline__ unsigned cvt_pk_bf16(float lo, float hi) { unsigned r; asm volatile("v_cvt_pk_bf16_f32 %0, %1, %2" : "=v"(r) : "v"(lo), "v"(hi)); return r; }
typedef float f32x2 __attribute__((ext_vector_type(2)));
__device__ __forceinline__ f32x2 gelu_pk(f32x2 v) {
    const f32x2 av = __builtin_elementwise_abs(v), d = av * 0.2316418882f + 1.0f;
    f32x2 t; t.x = __builtin_amdgcn_rcpf(d.x); t.y = __builtin_amdgcn_rcpf(d.y);
    f32x2 q = t * 0.5307027145f + (-0.7265760135f); q = q * t + 0.7107068705f; q = q * t + (-0.142248368f); q = q * t + 0.127414796f; q = q * t;
    const f32x2 s = (v * v) * (-0.72134752044f);
    f32x2 e; e.x = __builtin_amdgcn_exp2f(s.x); e.y = __builtin_amdgcn_exp2f(s.y);
    const f32x2 m = v * (q * e), r = v - m;
    f32x2 o; o.x = v.x < 0.f ? m.x : r.x; o.y = v.y < 0.f ? m.y : r.y; return o;
}

template <int ACT  > struct EpiBf16 {
    static constexpr bool PERM = true, AFTER_DRAIN = false; static_assert(ACT == 0 || ACT == 1, "EpiBf16: ACT is 0 (none) or 1 (gelu_pk)");
    bf16_t* O; int ldc; const float* bias; int split_cols; size_t split_stride; float scale0;
    __device__ __forceinline__ void operator()(const f32x4 (&acc)[2][2][4][2], const Unit& u, int wr, int wc, int fr, int fq) const {
        const int row0 = u.pm * BM + wr * 64 + fr; int colt = u.pn * BM; bf16_t* base = O;
        float sc = 1.f; if (split_cols) { const int t = colt / split_cols; base += (size_t)t * split_stride; colt -= t * split_cols; if (t == 0) sc = scale0; }
        const int col0 = colt + wc * 32 + 8 * fq, bcol0 = u.pn * BM + wc * 32 + 8 * fq;
        f32x4 bv[2][2];
#pragma unroll
        for (int bj = 0; bj < 2; ++bj)
#pragma unroll
            for (int n = 0; n < 2; ++n) bv[bj][n] = bias ? *(const f32x4*)(bias + bcol0 + bj * HALF + 4 * n) : (f32x4){0.f, 0.f, 0.f, 0.f};
#pragma unroll
        for (int ai = 0; ai < 2; ++ai)
#pragma unroll
            for (int m = 0; m < 4; ++m) { bf16_t* rowp = base + (size_t)(row0 + ai * HALF + m * 16) * ldc + col0;
#pragma unroll
                for (int bj = 0; bj < 2; ++bj) { f32x4 v0 = acc[ai][bj][m][0] + bv[bj][0], v1 = acc[ai][bj][m][1] + bv[bj][1];
                    if (ACT == 1) { f32x2 a = gelu_pk((f32x2){v0[0], v0[1]}), b = gelu_pk((f32x2){v0[2], v0[3]}), c = gelu_pk((f32x2){v1[0], v1[1]}), d = gelu_pk((f32x2){v1[2], v1[3]});
                        v0 = (f32x4){a.x, a.y, b.x, b.y}; v1 = (f32x4){c.x, c.y, d.x, d.y}; }
                    v0 = v0 * sc; v1 = v1 * sc; u32x4 w; w.x = cvt_pk_bf16(v0[0], v0[1]); w.y = cvt_pk_bf16(v0[2], v0[3]); w.z = cvt_pk_bf16(v1[0], v1[1]); w.w = cvt_pk_bf16(v1[2], v1[3]);
                    *(u32x4*)(rowp + bj * HALF) = w; } }
    }
};
template <class Epi, class Sched, bool ALIGN_EPI = false, bool SP2 = false>
__device__ __forceinline__ void gemm_phase(PG8_LAS unsigned char* lds, const Gemm g, const Sched& S, const Epi& E) {
    int tid_ = threadIdx.x; asm volatile("" : "+v"(tid_));
    const int tid = tid_, wid = __builtin_amdgcn_readfirstlane(tid >> 6), lane = tid & 63, wr = wid >> 2, wc = wid & 3, fr = lane & 15, fq = lane >> 4;
    const int K = g.K, nt_full = K / BK;
    unsigned voffA[2], voffB[2];
#pragma unroll
    for (int i = 0; i < 2; ++i) { int R, C; stage_rc(tid * 16 + i * 8192, R, C); const int Rb = Epi::PERM ? ((R & ~31) + perm32(R & 31)) : R;
        voffA[i] = (unsigned)(R * K + C) * 2u; voffB[i] = (unsigned)(Rb * K + C) * 2u; }
    const size_t kstep = (size_t)(BK * 2);
    const size_t hstep = (size_t)HALF * K * 2;
    const size_t tstep = 2 * hstep;
    const unsigned ldsw = (unsigned)wid * 1024u;
    const int aoff = lds_byte(wr * 64 + fr, fq * 8), boff = lds_byte(wc * 32 + fr, fq * 8);
#define PG8_SA(b, h) (((b) * 2 + (h)) * HTB)
#define PG8_SB(b, h) ((4 + (b) * 2 + (h)) * HTB)
#define PG8_STAGE(bufoff, gbase, voff) do { _Pragma("unroll") for (int _i = 0; _i < 2; ++_i) \
        __builtin_amdgcn_global_load_lds((const unsigned*)((const char*)(gbase) + (voff)[_i]), (PG8_LAS unsigned*)(lds + (bufoff) + ldsw + _i * 8192), 16, 0, 0); } while (0)
#define PG8_LDA(dst, b, h) do { _Pragma("unroll") for (int m = 0; m < 4; ++m) _Pragma("unroll") for (int k = 0; k < 2; ++k) dst[m][k] = *(const PG8_LAS bf16x8*)(lds + PG8_SA(b, h) + aoff + m * 2048 + k * 1024); } while (0)
#define PG8_LDB(dst, b, h) do { _Pragma("unroll") for (int n = 0; n < 2; ++n) _Pragma("unroll") for (int k = 0; k < 2; ++k) dst[n][k] = *(const PG8_LAS bf16x8*)(lds + PG8_SB(b, h) + boff + n * 2048 + k * 1024); } while (0)
#define PG8_MMA(ai, bj, At, Bt) do { __builtin_amdgcn_s_setprio(1); _Pragma("unroll") for (int m = 0; m < 4; ++m) _Pragma("unroll") for (int n = 0; n < 2; ++n) _Pragma("unroll") for (int k = 0; k < 2; ++k) \
        acc[ai][bj][m][n] = __builtin_amdgcn_mfma_f32_16x16x32_bf16(Bt[n][k], At[m][k], acc[ai][bj][m][n], 0, 0, 0); __builtin_amdgcn_s_setprio(0); } while (0)
#define PG8_WAIT_V(n) asm volatile("s_waitcnt vmcnt(" #n ")" ::: "memory")
#define PG8_WAIT_L(n) asm volatile("s_waitcnt lgkmcnt(" #n ")" ::: "memory")
#define PG8_BAR __builtin_amdgcn_s_barrier()
#define PG8_SCHED __builtin_amdgcn_sched_barrier(0)
    Unit cur, nxt; int ui = 0;
    if (!S.next(0, cur)) return;
    f32x4 acc[2][2][4][2];
#pragma unroll
    for (int a = 0; a < 2; ++a)
#pragma unroll
        for (int b = 0; b < 2; ++b)
#pragma unroll
            for (int m = 0; m < 4; ++m)
#pragma unroll
                for (int n = 0; n < 2; ++n) acc[a][b][m][n] = (f32x4){0.f, 0.f, 0.f, 0.f};
    bf16x8 At[4][2], B0[2][2], B1[2][2];
    int nt = S.nkt(cur, nt_full);
    const char* cA = (const char*)g.A + (size_t)cur.pm * tstep + (size_t)S.kt0(cur) * kstep; const char* cB = (const char*)g.Bt + (size_t)(cur.pn & 255) * tstep + (size_t)S.kt0(cur) * kstep;
    S.a_ready(cur);
    if constexpr (SP2) {
        PG8_STAGE(PG8_SB(0, 0), cB, voffB); PG8_STAGE(PG8_SB(0, 1), cB + hstep, voffB); PG8_STAGE(PG8_SA(0, 0), cA, voffA); PG8_STAGE(PG8_SA(0, 1), cA + hstep, voffA);
        if (wr == 1) PG8_BAR;
        PG8_WAIT_V(2); PG8_BAR;
        PG8_STAGE(PG8_SB(1, 0), cB + kstep, voffB); PG8_STAGE(PG8_SA(1, 0), cA + kstep, voffA); PG8_STAGE(PG8_SB(1, 1), cB + hstep + kstep, voffB);
        PG8_WAIT_V(6); PG8_BAR;
    } else {
        PG8_STAGE(PG8_SB(0, 0), cB, voffB); PG8_STAGE(PG8_SA(0, 0), cA, voffA); PG8_STAGE(PG8_SB(0, 1), cB + hstep, voffB); PG8_STAGE(PG8_SA(0, 1), cA + hstep, voffA);
        if (wr == 1) PG8_BAR;
        PG8_WAIT_V(4); PG8_BAR;
        PG8_STAGE(PG8_SB(1, 0), cB + kstep, voffB); PG8_STAGE(PG8_SA(1, 0), cA + kstep, voffA); PG8_STAGE(PG8_SB(1, 1), cB + hstep + kstep, voffB);
        PG8_WAIT_V(6); PG8_BAR;
    }
    for (;;) {
        const bool has_next = S.next(ui + 1, nxt);
        const char* nA = has_next ? (const char*)g.A + (size_t)nxt.pm * tstep + (size_t)S.kt0(nxt) * kstep : cA; const char* nB = has_next ? (const char*)g.Bt + (size_t)(nxt.pn & 255) * tstep + (size_t)S.kt0(nxt) * kstep : cB;
        for (int t = 0; t < nt; t += 2) {
            const bool last = (t == nt - 2);
            const char* a1 = cA + (size_t)(t + 1) * kstep;
            const char* a2 = last ? nA : cA + (size_t)(t + 2) * kstep; const char* b2 = last ? nB : cB + (size_t)(t + 2) * kstep;
            const char* a3 = a2 + kstep; const char* b3 = b2 + kstep;
            if (last && has_next) S.a_ready(nxt);
            if constexpr (SP2) {
            PG8_LDB(B0, 0, 0); PG8_LDB(B1, 0, 1); PG8_SCHED; PG8_LDA(At, 0, 0); PG8_STAGE(PG8_SA(1, 1), a1 + hstep, voffA);
            PG8_WAIT_V(8); PG8_WAIT_L(0); PG8_BAR; PG8_MMA(0, 0, At, B0); PG8_MMA(0, 1, At, B1); PG8_BAR; PG8_SCHED;
            PG8_LDA(At, 0, 1); PG8_STAGE(PG8_SB(0, 0), b2, voffB); PG8_STAGE(PG8_SB(0, 1), b2 + hstep, voffB); PG8_STAGE(PG8_SA(0, 0), a2, voffA);
            PG8_WAIT_V(8); PG8_WAIT_L(0); PG8_BAR; PG8_MMA(1, 0, At, B0); PG8_MMA(1, 1, At, B1); PG8_BAR; PG8_SCHED;
            PG8_LDB(B0, 1, 0); PG8_LDB(B1, 1, 1); PG8_SCHED; PG8_LDA(At, 1, 0); PG8_STAGE(PG8_SA(0, 1), a2 + hstep, voffA);
            PG8_WAIT_V(8); PG8_WAIT_L(0); PG8_BAR; PG8_MMA(0, 0, At, B0); PG8_MMA(0, 1, At, B1); PG8_BAR; PG8_SCHED;
            PG8_LDA(At, 1, 1); PG8_STAGE(PG8_SB(1, 0), b3, voffB); PG8_STAGE(PG8_SB(1, 1), b3 + hstep, voffB); PG8_STAGE(PG8_SA(1, 0), a3, voffA);
            PG8_WAIT_V(8); PG8_WAIT_L(0); PG8_BAR; PG8_MMA(1, 0, At, B0); PG8_MMA(1, 1, At, B1); PG8_BAR; PG8_SCHED;
            } else {
            PG8_LDB(B0, 0, 0); PG8_SCHED; PG8_LDA(At, 0, 0); PG8_STAGE(PG8_SA(1, 1), a1 + hstep, voffA);
            PG8_WAIT_L(8); PG8_BAR; PG8_WAIT_L(0); PG8_MMA(0, 0, At, B0); PG8_BAR; PG8_SCHED;
            PG8_LDB(B1, 0, 1); PG8_STAGE(PG8_SB(0, 0), b2, voffB);
            PG8_BAR; PG8_WAIT_L(0); PG8_MMA(0, 1, At, B1); PG8_BAR;
            PG8_LDA(At, 0, 1); PG8_STAGE(PG8_SA(0, 0), a2, voffA);
            PG8_BAR; PG8_WAIT_L(0); PG8_MMA(1, 0, At, B0); PG8_BAR; PG8_SCHED;
            PG8_STAGE(PG8_SB(0, 1), b2 + hstep, voffB);
            PG8_WAIT_V(6); PG8_BAR; PG8_MMA(1, 1, At, B1); PG8_BAR;
            PG8_LDB(B0, 1, 0); PG8_SCHED; PG8_LDA(At, 1, 0); PG8_STAGE(PG8_SA(0, 1), a2 + hstep, voffA);
            PG8_WAIT_L(8); PG8_BAR; PG8_WAIT_L(0); PG8_MMA(0, 0, At, B0); PG8_BAR; PG8_SCHED;
            PG8_LDB(B1, 1, 1); PG8_STAGE(PG8_SB(1, 0), b3, voffB);
            PG8_BAR; PG8_WAIT_L(0); PG8_MMA(0, 1, At, B1); PG8_BAR;
            PG8_LDA(At, 1, 1); PG8_STAGE(PG8_SA(1, 0), a3, voffA);
            PG8_BAR; PG8_WAIT_L(0); PG8_MMA(1, 0, At, B0); PG8_BAR; PG8_SCHED;
            PG8_STAGE(PG8_SB(1, 1), b3 + hstep, voffB);
            PG8_WAIT_V(6); PG8_BAR; PG8_MMA(1, 1, At, B1); PG8_BAR;
            }
        }
        if constexpr (ALIGN_EPI) { if (wr == 0) PG8_BAR; }
        if constexpr (!Epi::AFTER_DRAIN) { E(acc, cur, wr, wc, fr, fq); S.done(cur); }
        if (!has_next) break;
#pragma unroll
        for (int a = 0; a < 2; ++a)
#pragma unroll
            for (int b = 0; b < 2; ++b)
#pragma unroll
                for (int m = 0; m < 4; ++m)
#pragma unroll
                    for (int n = 0; n < 2; ++n) acc[a][b][m][n] = (f32x4){0.f, 0.f, 0.f, 0.f};
        cur = nxt; cA = nA; cB = nB; ++ui; nt = S.nkt(cur, nt_full);
        if constexpr (ALIGN_EPI) { if (wr == 1) PG8_BAR; }
    }
    PG8_WAIT_V(0);
    if constexpr (!ALIGN_EPI) { if (wr == 0) PG8_BAR; }
    PG8_BAR;
    if constexpr (Epi::AFTER_DRAIN) { E.fused(acc, cur, wr, wc, fr, fq, lds, wid, lane); S.done(cur); }
#undef PG8_SA
#undef PG8_SB
#undef PG8_STAGE
#undef PG8_LDA
#undef PG8_LDB
#undef PG8_MMA
#undef PG8_WAIT_V
#undef PG8_WAIT_L
#undef PG8_BAR
#undef PG8_SCHED
}
}

constexpr int DM = 1024, NB = 8, SEQ = 4096, CTXL = 256, TPB = SEQ + CTXL  , MTOT = NB * TPB  , DFF = 2816;
constexpr int NMOD = 9;
constexpr float EPSN = 1e-6f;
constexpr float LOG2E = 1.4426950408889634f;
constexpr int NWAVES = 8;

constexpr size_t MiB = 1u << 20;
constexpr size_t WS_ROPE = 64 * 1024;
constexpr size_t WS_MOD = 1 * MiB;
constexpr size_t WS_W0 = 2 * MiB;
constexpr size_t SZ_WGU = (size_t)2 * DFF * DM * 2;
constexpr size_t SZ_WD = (size_t)DM * DFF * 2;
constexpr size_t W0_WGU0 = WS_W0, W0_WD0 = W0_WGU0 + SZ_WGU, W0_WGU1 = W0_WD0 + SZ_WD, W0_WD1 = W0_WGU1 + SZ_WGU;
constexpr size_t W0_WAB = W0_WD1 + SZ_WD;
constexpr size_t W0_WOUT = W0_WAB + (size_t)2560 * 1024 * 2;
constexpr size_t W0_END = W0_WOUT + (size_t)1024 * 1024 * 2;
static_assert(W0_END <= 42 * MiB, "W0");
constexpr size_t WS_DFTL = 42 * MiB;
constexpr size_t WS_DFTC = 106 * MiB;
constexpr size_t WS_W1 = 80 * MiB;
constexpr size_t W1_WGU0 = WS_W1, W1_WD0 = W1_WGU0 + SZ_WGU, W1_WGU1 = W1_WD0 + SZ_WD, W1_WD1 = W1_WGU1 + SZ_WGU;
constexpr size_t W1_WIN = W1_WD1 + SZ_WD;
constexpr size_t W1_WUQ = W1_WIN + (size_t)768 * 1024 * 2;
constexpr size_t W1_WUKV = W1_WUQ + (size_t)1536 * 384 * 2;
constexpr size_t W1_WO = W1_WUKV + (size_t)2048 * 256 * 2;
constexpr size_t W1_END = W1_WO + (size_t)1024 * 1536 * 2;
static_assert(W1_END <= 120 * MiB, "W1");
constexpr size_t WS_VB = 2 * MiB;
static_assert(WS_VB + (size_t)MTOT * 1024 * 2 <= WS_W1, "VB");
constexpr size_t WS_H = 120 * MiB;
constexpr size_t WS_A = 188 * MiB;
constexpr size_t WS_X = 375 * MiB;
constexpr size_t WS_END = WS_X + (size_t)MTOT * DM * 4;
static_assert(WS_END <= 512 * MiB, "ws");
static_assert(WS_A + (size_t)MTOT * DFF * 2 <= WS_X, "ACT");
constexpr size_t A_PQL = WS_A;
constexpr size_t A_PQC = WS_A + 64 * MiB;
constexpr size_t A_QN = WS_A + 68 * MiB;
constexpr size_t A_KNA = WS_A + 102 * MiB;
constexpr size_t A_VT = WS_A + 136 * MiB;
constexpr size_t A_Z = WS_A;
constexpr size_t A_QB = WS_A;
constexpr size_t A_CQ = WS_A + 102 * MiB;
constexpr size_t A_CKV = WS_A + 128 * MiB;
constexpr size_t A_KR = WS_A + 145 * MiB;
static_assert(A_KR + (size_t)MTOT * 64 * 2 <= WS_X, "A");

constexpr int LDS_BYTES = 135168;

typedef unsigned short bf16_t;
typedef short bf16x8 __attribute__((ext_vector_type(8)));
typedef float f32x4 __attribute__((ext_vector_type(4)));
typedef float f32x16 __attribute__((ext_vector_type(16)));
typedef unsigned u32x4 __attribute__((ext_vector_type(4)));
typedef unsigned u32x2 __attribute__((ext_vector_type(2)));
#define LAS __attribute__((address_space(3)))

__device__ __forceinline__ unsigned f2bf(float f) { unsigned u = __builtin_bit_cast(unsigned, f); return (u + 0x7fffu + ((u >> 16) & 1u)) >> 16; }
__device__ __forceinline__ unsigned pk2(float lo, float hi) { return pg8::cvt_pk_bf16(lo, hi); }
__device__ __forceinline__ float wave_sum(float v) {
#pragma unroll
    for (int o = 1; o < 64; o <<= 1) v += __shfl_xor(v, o);
    return v;
}
__device__ __forceinline__ float silu_f(float x) { return x * __builtin_amdgcn_rcpf(1.0f + __expf(-x)); }
__device__ __forceinline__ const float* in_row(const float* xin, const float* cin, int row) {
    const int b = row / TPB, t = row - b * TPB;
    return t < SEQ ? xin + ((size_t)b * SEQ + t) * DM : cin + ((size_t)b * CTXL + (t - SEQ)) * DM;
}

struct RotOrder {
    pg8::StaticOrder S;
    __device__ __forceinline__ void init(int M, int N, int G, int c, int rot) { S.init(M, N, G, (c + rot) % G); }
    __device__ __forceinline__ bool next(int i, pg8::Unit& u) const { return S.next(i, u); }
    __device__ __forceinline__ void a_ready(const pg8::Unit&) const {}
    __device__ __forceinline__ void done(const pg8::Unit&) const {}
    __device__ __forceinline__ int kt0(const pg8::Unit&) const { return 0; }
    __device__ __forceinline__ int nkt(const pg8::Unit&, int full) const { return full; }
};
constexpr int TAIL_ROW0 = 128 * 256, TAIL_ROWS = 8 * 256;
template <int NP> struct TailOrder {
    int G, c, ntk;
    __device__ __forceinline__ void init(int K, int G_, int c_) { G = G_; c = c_; ntk = K / 64; }
    __device__ __forceinline__ bool next(int i, pg8::Unit& u) const {
        const int L = i * G + c; if (L >= 32 * NP) return false;
        const int t = L / NP, p = L % NP;
        u.pm = 128 + (t & 7); u.pn = (t >> 3) | ((p + 1) << 8); return true;
    }
    __device__ __forceinline__ int kt0(const pg8::Unit& u) const { const int p = (u.pn >> 8) - 1, per2 = (ntk / 2) / NP, rem = (ntk / 2) % NP; return 2 * (p * per2 + (p < rem ? p : rem)); }
    __device__ __forceinline__ int nkt(const pg8::Unit& u, int full) const { const int p = (u.pn >> 8) - 1, per2 = (ntk / 2) / NP, rem = (ntk / 2) % NP; return 2 * (per2 + (p < rem ? 1 : 0)); }
    __device__ __forceinline__ void a_ready(const pg8::Unit&) const {}
    __device__ __forceinline__ void done(const pg8::Unit&) const {}
};
struct DftPieceOrder {
    pg8::StaticOrder S; int G, c;
    __device__ __forceinline__ void init(int G_, int c_) { S.init(2048, 4096, 1, 0); G = G_; c = c_; }
    __device__ __forceinline__ bool next(int i, pg8::Unit& u) const { const int L = i * G + c; if (L >= 256) return false; S.next(L >> 1, u); u.pn |= ((L & 1) + 1) << 8; return true; }
    __device__ __forceinline__ int kt0(const pg8::Unit& u) const { return ((u.pn >> 8) - 1) * 64; }
    __device__ __forceinline__ int nkt(const pg8::Unit&, int) const { return 64; }
    __device__ __forceinline__ void a_ready(const pg8::Unit&) const {}
    __device__ __forceinline__ void done(const pg8::Unit&) const {}
};
struct EpiEF {
    static constexpr bool PERM = false, AFTER_DRAIN = false;
    float* EF;
    __device__ __forceinline__ void operator()(const pg8::f32x4 (&acc)[2][2][4][2], const pg8::Unit& u, int wr, int wc, int fr, int fq) const {
        const int piece = (u.pn >> 8) - 1, pn = u.pn & 255;
        const int row0 = u.pm * 256 + wr * 64 + fr, col0 = pn * 256 + wc * 32 + 4 * fq;
        float* base = EF + (size_t)piece * 2048 * 4096;
#pragma unroll
        for (int ai = 0; ai < 2; ++ai)
#pragma unroll
            for (int m = 0; m < 4; ++m)
#pragma unroll
                for (int bj = 0; bj < 2; ++bj)
#pragma unroll
                    for (int n = 0; n < 2; ++n) *(f32x4*)(base + (size_t)(row0 + ai * 128 + m * 16) * 4096 + col0 + bj * 128 + n * 16) = acc[ai][bj][m][n];
    }
};
struct LatentOrder {
    pg8::StaticOrder S;
    __device__ __forceinline__ void init(int N, int G, int c) { S.init(NB * SEQ, N, G, c); }
    __device__ __forceinline__ bool next(int i, pg8::Unit& u) const { if (!S.next(i, u)) return false; u.pm = (u.pm >> 4) * 17 + (u.pm & 15); return true; }
    __device__ __forceinline__ void a_ready(const pg8::Unit&) const {}
    __device__ __forceinline__ void done(const pg8::Unit&) const {}
    __device__ __forceinline__ int kt0(const pg8::Unit&) const { return 0; }
    __device__ __forceinline__ int nkt(const pg8::Unit&, int full) const { return full; }
};

struct EpiSwiGLU {
    static constexpr bool PERM = true, AFTER_DRAIN = false;
    bf16_t* O;
    __device__ __forceinline__ void operator()(const pg8::f32x4 (&acc)[2][2][4][2], const pg8::Unit& u, int wr, int wc, int fr, int fq) const {
        const int row0 = u.pm * 256 + wr * 64 + fr, col0 = u.pn * 128 + wc * 32 + 8 * fq;
#pragma unroll
        for (int ai = 0; ai < 2; ++ai)
#pragma unroll
            for (int m = 0; m < 4; ++m) {
                const f32x4 g0 = acc[ai][0][m][0], g1 = acc[ai][0][m][1], u0 = acc[ai][1][m][0], u1 = acc[ai][1][m][1];
                u32x4 w;
                w.x = pk2(silu_f(g0[0]) * u0[0], silu_f(g0[1]) * u0[1]); w.y = pk2(silu_f(g0[2]) * u0[2], silu_f(g0[3]) * u0[3]);
                w.z = pk2(silu_f(g1[0]) * u1[0], silu_f(g1[1]) * u1[1]); w.w = pk2(silu_f(g1[2]) * u1[2], silu_f(g1[3]) * u1[3]);
                *(u32x4*)(O + (size_t)(row0 + ai * 128 + m * 16) * DFF + col0) = w;
            }
    }
};
struct EpiResid {
    static constexpr bool PERM = false, AFTER_DRAIN = false;
    float* X; const float* modL; int jgate; float coef;
    __device__ __forceinline__ void operator()(const pg8::f32x4 (&acc)[2][2][4][2], const pg8::Unit& u, int wr, int wc, int fr, int fq) const {
        const int row0 = u.pm * 256 + wr * 64 + fr, col0 = u.pn * 256 + wc * 32 + 4 * fq;
        const int b = u.pm / 17, isc = (u.pm - b * 17) == 16;
        const float* mrow = modL + ((size_t)(isc ? 8 : b) * NMOD + jgate) * DM;
        f32x4 gv[2][2];
#pragma unroll
        for (int bj = 0; bj < 2; ++bj)
#pragma unroll
            for (int n = 0; n < 2; ++n) gv[bj][n] = *(const f32x4*)(mrow + col0 + bj * 128 + n * 16) * coef;
#pragma unroll
        for (int ai = 0; ai < 2; ++ai)
#pragma unroll
            for (int m = 0; m < 4; ++m) {
                float* orow = X + (size_t)(row0 + ai * 128 + m * 16) * DM;
#pragma unroll
                for (int bj = 0; bj < 2; ++bj)
#pragma unroll
                    for (int n = 0; n < 2; ++n) {
                        const int c = col0 + bj * 128 + n * 16;
                        const f32x4 bs = *(const f32x4*)(orow + c);
                        *(f32x4*)(orow + c) = bs + gv[bj][n] * acc[ai][bj][m][n];
                    }
                if (m == 3) asm volatile("" ::: "memory");
            }
    }
};
struct EpiResidIn {
    static constexpr bool PERM = false, AFTER_DRAIN = false;
    const float* xin; const float* cin; float* X; const float* modL; int jgate; float coef;
    __device__ __forceinline__ void operator()(const pg8::f32x4 (&acc)[2][2][4][2], const pg8::Unit& u, int wr, int wc, int fr, int fq) const {
        const int row0 = u.pm * 256 + wr * 64 + fr, col0 = u.pn * 256 + wc * 32 + 4 * fq;
        const int b = u.pm / 17, isc = (u.pm - b * 17) == 16;
        const float* mrow = modL + ((size_t)(isc ? 8 : b) * NMOD + jgate) * DM;
        const float* src = isc ? cin + (size_t)b * CTXL * DM : xin + ((size_t)b * SEQ + (size_t)(u.pm - b * 17) * 256) * DM;
        f32x4 gv[2][2];
#pragma unroll
        for (int bj = 0; bj < 2; ++bj)
#pragma unroll
            for (int n = 0; n < 2; ++n) gv[bj][n] = *(const f32x4*)(mrow + col0 + bj * 128 + n * 16) * coef;
#pragma unroll
        for (int ai = 0; ai < 2; ++ai)
#pragma unroll
            for (int m = 0; m < 4; ++m) {
                const int rl = wr * 64 + fr + ai * 128 + m * 16;
                const float* brow = src + (size_t)rl * DM;
                float* orow = X + (size_t)(u.pm * 256 + rl) * DM;
#pragma unroll
                for (int bj = 0; bj < 2; ++bj)
#pragma unroll
                    for (int n = 0; n < 2; ++n) {
                        const int c = col0 + bj * 128 + n * 16;
                        const f32x4 bs = *(const f32x4*)(brow + c);
                        *(f32x4*)(orow + c) = bs + gv[bj][n] * acc[ai][bj][m][n];
                    }
                if (m == 3) asm volatile("" ::: "memory");
            }
    }
};
struct EpiPartial {
    static constexpr bool PERM = false, AFTER_DRAIN = false;
    float* P; const float* modL; int jgate; float coef;
    __device__ __forceinline__ void operator()(const pg8::f32x4 (&acc)[2][2][4][2], const pg8::Unit& u, int wr, int wc, int fr, int fq) const {
        const int piece = (u.pn >> 8) - 1, pn = u.pn & 255;
        const int row0 = (u.pm - 128) * 256 + wr * 64 + fr, col0 = pn * 256 + wc * 32 + 4 * fq;
        const int b = u.pm / 17, isc = (u.pm - b * 17) == 16;
        const float* mrow = modL + ((size_t)(isc ? 8 : b) * NMOD + jgate) * DM;
        float* pb = P + (size_t)piece * TAIL_ROWS * DM;
#pragma unroll
        for (int bj = 0; bj < 2; ++bj)
#pragma unroll
            for (int n = 0; n < 2; ++n) {
                const int c = col0 + bj * 128 + n * 16;
                const f32x4 gv = *(const f32x4*)(mrow + c) * coef;
#pragma unroll
                for (int ai = 0; ai < 2; ++ai)
#pragma unroll
                    for (int m = 0; m < 4; ++m) *(f32x4*)(pb + (size_t)(row0 + ai * 128 + m * 16) * DM + c) = gv * acc[ai][bj][m][n];
            }
    }
};
struct EpiPQT {
    static constexpr bool PERM = true, AFTER_DRAIN = false;
    bf16_t* PQl; bf16_t* PQc;
    __device__ __forceinline__ void operator()(const pg8::f32x4 (&acc)[2][2][4][2], const pg8::Unit& u, int wr, int wc, int fr, int fq) const {
        const int b = u.pn / 17, tt = u.pn - b * 17, isc = tt == 16;
        const int part = u.pm >> 1;
        const int j0 = (u.pm & 1) * 256 + wr * 64 + fr;
#pragma unroll
        for (int ai = 0; ai < 2; ++ai)
#pragma unroll
            for (int m = 0; m < 4; ++m) {
                const int j = j0 + ai * 128 + m * 16;
#pragma unroll
                for (int bj = 0; bj < 2; ++bj) {
                    const int tl = bj * 128 + wc * 32 + 8 * fq;
                    bf16_t* dst = isc ? PQc + ((size_t)(b * 512 + j) * 2 + part) * CTXL + tl
                                      : PQl + ((size_t)(b * 512 + j) * 2 + part) * SEQ + tt * 256 + tl;
                    const f32x4 v0 = acc[ai][bj][m][0], v1 = acc[ai][bj][m][1];
                    u32x4 w; w.x = pk2(v0[0], v0[1]); w.y = pk2(v0[2], v0[3]); w.z = pk2(v1[0], v1[1]); w.w = pk2(v1[2], v1[3]);
                    *(u32x4*)dst = w;
                }
            }
    }
};
struct EpiDFT {
    static constexpr bool PERM = true, AFTER_DRAIN = false;
    bf16_t* CAT; int tok_off;
    __device__ __forceinline__ void operator()(const pg8::f32x4 (&acc)[2][2][4][2], const pg8::Unit& u, int wr, int wc, int fr, int fq) const {
        const int k0 = u.pm * 256 + wr * 64 + fr;
#pragma unroll
        for (int ai = 0; ai < 2; ++ai)
#pragma unroll
            for (int m = 0; m < 4; ++m) {
                const int k = k0 + ai * 128 + m * 16;
#pragma unroll
                for (int bj = 0; bj < 2; ++bj) {
                    const int c = u.pn * 256 + bj * 128 + wc * 32 + 8 * fq, b = c >> 9, j = c & 511;
                    const f32x4 v0 = acc[ai][bj][m][0], v1 = acc[ai][bj][m][1];
                    u32x4 w; w.x = pk2(v0[0], v0[1]); w.y = pk2(v0[2], v0[3]); w.z = pk2(v1[0], v1[1]); w.w = pk2(v1[2], v1[3]);
                    *(u32x4*)(CAT + (size_t)(b * TPB + tok_off + k) * 1024 + j) = w;
                }
            }
    }
};
struct EpiZ {
    static constexpr bool PERM = false, AFTER_DRAIN = false;
    float* Z;
    __device__ __forceinline__ void operator()(const pg8::f32x4 (&acc)[2][2][4][2], const pg8::Unit& u, int wr, int wc, int fr, int fq) const {
        const int row0 = u.pm * 256 + wr * 64 + fr, col0 = u.pn * 256 + wc * 32 + 4 * fq;
#pragma unroll
        for (int ai = 0; ai < 2; ++ai)
#pragma unroll
            for (int m = 0; m < 4; ++m)
#pragma unroll
                for (int bj = 0; bj < 2; ++bj)
#pragma unroll
                    for (int n = 0; n < 2; ++n) {
                        const int c = col0 + bj * 128 + n * 16;
                        if (c < 576) *(f32x4*)(Z + (size_t)(row0 + ai * 128 + m * 16) * 576 + c) = acc[ai][bj][m][n];
                    }
    }
};
struct EpiQRope {
    static constexpr bool PERM = false, AFTER_DRAIN = false;
    bf16_t* QB; const float* cosT; const float* sinT;
    __device__ __forceinline__ void operator()(const pg8::f32x4 (&acc)[2][2][4][2], const pg8::Unit& u, int wr, int wc, int fr, int fq) const {
        const int row0 = u.pm * 256 + wr * 64 + fr;
#pragma unroll
        for (int ai = 0; ai < 2; ++ai)
#pragma unroll
            for (int m = 0; m < 4; ++m) {
                const int row = row0 + ai * 128 + m * 16, t = row % TPB, gr = (t >> 6) & 63, gc = t & 63;
#pragma unroll
                for (int bj = 0; bj < 2; ++bj) {
                    const int cbase = u.pn * 256 + bj * 128 + wc * 32, g6 = (cbase % 192) >> 5;
                    f32x4 v0 = acc[ai][bj][m][0], v1 = acc[ai][bj][m][1];
                    if (g6 >= 4) {
                        const int pos = (g6 == 4) ? gr : gc;
                        const f32x4 c4 = *(const f32x4*)(cosT + pos * 16 + 4 * fq), s4 = *(const f32x4*)(sinT + pos * 16 + 4 * fq);
                        const f32x4 a = v0, bb = v1;
                        v0 = a * c4 - bb * s4; v1 = bb * c4 + a * s4;
                    }
                    bf16_t* dst = QB + (size_t)row * 1536 + cbase + 4 * fq;
                    u32x2 w0, w1; w0.x = pk2(v0[0], v0[1]); w0.y = pk2(v0[2], v0[3]); w1.x = pk2(v1[0], v1[1]); w1.y = pk2(v1[2], v1[3]);
                    *(u32x2*)dst = w0; *(u32x2*)(dst + 16) = w1;
                }
            }
    }
};

#define LDS_WAIT() asm volatile("s_waitcnt lgkmcnt(0)" ::: "memory")

__device__ __forceinline__ void norm_pass(const float* X, const float* xin, const float* cin, const float* g, const float* modL, int jshift, int jscale,
                                          bf16_t* H, bool latent_only, int gw, int NGW, int lane, float* Xcopy = nullptr, const float* Pbuf = nullptr, int npieces = 0) {
    f32x4 vn[4];
    if (gw < MTOT) { const float* s0 = X ? X + (size_t)gw * DM : in_row(xin, cin, gw);
#pragma unroll
        for (int j = 0; j < 4; ++j) vn[j] = *(const f32x4*)(s0 + 4 * lane + 256 * j); }
#pragma unroll 1
    for (int row = gw; row < MTOT; row += NGW) {
        f32x4 v[4];
#pragma unroll
        for (int j = 0; j < 4; ++j) v[j] = vn[j];
        const int nrow = row + NGW;
        if (nrow < MTOT) { const float* s1 = X ? X + (size_t)nrow * DM : in_row(xin, cin, nrow);
#pragma unroll
            for (int j = 0; j < 4; ++j) vn[j] = *(const f32x4*)(s1 + 4 * lane + 256 * j); }
        const int b = row / TPB, t = row - b * TPB; const bool isc = t >= SEQ;
        if (latent_only && isc) continue;
        const float* mrow = modL + (size_t)(isc ? 8 : b) * NMOD * DM;
        f32x4 gs[4], sh[4];
#pragma unroll
        for (int j = 0; j < 4; ++j) { const int c = 4 * lane + 256 * j; gs[j] = *(const f32x4*)(g + c) * (*(const f32x4*)(mrow + jscale * DM + c) + 1.0f); sh[j] = *(const f32x4*)(mrow + jshift * DM + c); }
        const bool tail = row >= TAIL_ROW0;
        if (Pbuf && tail) {
            for (int p = 0; p < npieces; ++p) {
#pragma unroll
                for (int j = 0; j < 4; ++j) v[j] += *(const f32x4*)(Pbuf + ((size_t)p * TAIL_ROWS + (row - TAIL_ROW0)) * DM + 4 * lane + 256 * j);
            }
        }
        float ss = 0.f;
#pragma unroll
        for (int j = 0; j < 4; ++j) ss += (v[j][0] * v[j][0] + v[j][1] * v[j][1]) + (v[j][2] * v[j][2] + v[j][3] * v[j][3]);
        const float rstd = 1.0f / sqrtf(wave_sum(ss) * (1.0f / DM) + EPSN);
        if (Xcopy && tail && (X == nullptr || Pbuf)) {
#pragma unroll
            for (int j = 0; j < 4; ++j) *(f32x4*)(Xcopy + (size_t)row * DM + 4 * lane + 256 * j) = v[j];
        }
#pragma unroll
        for (int j = 0; j < 4; ++j) {
            const int c = 4 * lane + 256 * j;
            const f32x4 y = (v[j] * rstd) * gs[j] + sh[j];
            u32x2 w; w.x = pk2(y[0], y[1]); w.y = pk2(y[2], y[3]);
            *(u32x2*)(H + (size_t)row * DM + c) = w;
        }
    }
}
__device__ __forceinline__ void final_norm(const float* X, const float* g, float* out, int gw, int NGW, int lane) {
    f32x4 vn[4], g4[4];
#pragma unroll
    for (int j = 0; j < 4; ++j) g4[j] = *(const f32x4*)(g + 4 * lane + 256 * j);
    if (gw < NB * SEQ) { const int b0 = gw / SEQ; const float* s0 = X + (size_t)(b0 * TPB + (gw - b0 * SEQ)) * DM;
#pragma unroll
        for (int j = 0; j < 4; ++j) vn[j] = *(const f32x4*)(s0 + 4 * lane + 256 * j); }
#pragma unroll 1
    for (int r = gw; r < NB * SEQ; r += NGW) {
        f32x4 v[4]; float ss = 0.f;
#pragma unroll
        for (int j = 0; j < 4; ++j) v[j] = vn[j];
        const int nr = r + NGW;
        if (nr < NB * SEQ) { const int b1 = nr / SEQ; const float* s1 = X + (size_t)(b1 * TPB + (nr - b1 * SEQ)) * DM;
#pragma unroll
            for (int j = 0; j < 4; ++j) vn[j] = *(const f32x4*)(s1 + 4 * lane + 256 * j); }
#pragma unroll
        for (int j = 0; j < 4; ++j) ss += (v[j][0] * v[j][0] + v[j][1] * v[j][1]) + (v[j][2] * v[j][2] + v[j][3] * v[j][3]);
        const float rstd = 1.0f / sqrtf(wave_sum(ss) * (1.0f / DM) + EPSN);
#pragma unroll
        for (int j = 0; j < 4; ++j) { const int c = 4 * lane + 256 * j; *(f32x4*)(out + (size_t)r * DM + c) = (v[j] * rstd) * g4[j]; }
    }
}
__device__ __forceinline__ void mla_norm_pass(const float* Z, const float* gq, const float* gkv, const float* cosT, const float* sinT,
                                              bf16_t* CQ, bf16_t* CKV, bf16_t* KR, int gw, int NGW, int lane) {
    for (int row = gw; row < MTOT; row += NGW) {
        const int t = row % TPB; const bool isc = t >= SEQ;
        const float* z = Z + (size_t)row * 576;
        float q[6], kv[2]; float sq = 0.f, sk = 0.f;
#pragma unroll
        for (int i = 0; i < 6; ++i) { q[i] = z[lane + 64 * i]; sq += q[i] * q[i]; }
#pragma unroll
        for (int i = 0; i < 2; ++i) { kv[i] = z[384 + lane + 64 * i]; sk += kv[i] * kv[i]; }
        const float kr = z[512 + lane];
        const float rq = 1.0f / sqrtf(wave_sum(sq) * (1.0f / 384.0f) + EPSN), rk = 1.0f / sqrtf(wave_sum(sk) * (1.0f / 128.0f) + EPSN);
#pragma unroll
        for (int i = 0; i < 6; ++i) CQ[(size_t)row * 384 + lane + 64 * i] = (bf16_t)f2bf(q[i] * rq * gq[lane + 64 * i]);
#pragma unroll
        for (int i = 0; i < 2; ++i) { CKV[(size_t)row * 256 + lane + 64 * i] = (bf16_t)f2bf(kv[i] * rk * gkv[lane + 64 * i]); CKV[(size_t)row * 256 + 128 + lane + 64 * i] = 0; }
        const float pr = __shfl_xor(kr, 16);
        float o = kr;
        if (!isc) {
            const int pos = (lane < 32) ? (t >> 6) : (t & 63), j = lane & 15;
            const float c = cosT[pos * 16 + j], s = sinT[pos * 16 + j];
            o = (lane & 16) ? (kr * c + pr * s) : (kr * c - pr * s);
        }
        KR[(size_t)row * 64 + lane] = (bf16_t)f2bf(o);
    }
}

__device__ __forceinline__ void tr_item(const float* W, int ldn, int k0, int n0, bf16_t* dst, int ldw, LAS float* scr, int lane) {
#pragma unroll 16
    for (int i = 0; i < 32; ++i) { const int kk = 2 * i + (lane >> 5); scr[kk * 33 + (lane & 31)] = W[(size_t)(k0 + kk) * ldn + n0 + (lane & 31)]; }
    LDS_WAIT(); asm volatile("" ::: "memory");
    const int c = lane & 7;
#pragma unroll
    for (int j = 0; j < 4; ++j) { const int n = (lane >> 3) + 8 * j; const LAS float* s = scr + (8 * c) * 33 + n;
        u32x4 o; o.x = pk2(s[0 * 33], s[1 * 33]); o.y = pk2(s[2 * 33], s[3 * 33]); o.z = pk2(s[4 * 33], s[5 * 33]); o.w = pk2(s[6 * 33], s[7 * 33]);
        *(u32x4*)(dst + (size_t)n * ldw + 8 * c) = o; }
    LDS_WAIT(); asm volatile("" ::: "memory");
}
struct MapPlain { bf16_t* dst; int ldw; __device__ __forceinline__ bf16_t* operator()(int n0, int k0) const { return dst + (size_t)n0 * ldw + k0; } };
struct MapGU { bf16_t* dst; int which; static constexpr int ldw = 1024; __device__ __forceinline__ bf16_t* operator()(int n0, int k0) const { return dst + (size_t)((n0 >> 7) * 256 + which * 128 + (n0 & 127)) * 1024 + k0; } };
struct MapWo { bf16_t* dst; static constexpr int ldw = 1536; __device__ __forceinline__ bf16_t* operator()(int n0, int k0) const { return dst + (size_t)n0 * 1536 + (k0 >> 7) * 192 + (k0 & 127); } };
template <class Map> __device__ __forceinline__ void conv_w(const float* W, int ldn, int K, int N, const Map mp, LAS float* scr, int gw, int NGW, int lane, int rot) {
    const int nblk = N / 32, nitems = (K / 64) * nblk;
    for (int it = (gw + rot) % NGW; it < nitems; it += NGW) { const int kb = it / nblk, nb = it - kb * nblk; tr_item(W, ldn, 64 * kb, 32 * nb, mp(32 * nb, 64 * kb), mp.ldw, scr, lane); }
}
__device__ __forceinline__ void conv_ffn(const float* wg, const float* wu, const float* wd, int layer, unsigned char* ws, size_t off_gu0, size_t off_d0, size_t off_gu1, size_t off_d1,
                                         LAS float* scr, int gw, int NGW, int lane) {
#pragma unroll 1
    for (int f = 0; f < 2; ++f) {
        const size_t lf = (size_t)(layer * 2 + f);
        bf16_t* gu = (bf16_t*)(ws + (f ? off_gu1 : off_gu0)); bf16_t* d = (bf16_t*)(ws + (f ? off_d1 : off_d0));
        conv_w(wg + lf * DM * DFF, DFF, DM, DFF, MapGU{gu, 0}, scr, gw, NGW, lane, 0);
        conv_w(wu + lf * DM * DFF, DFF, DM, DFF, MapGU{gu, 1}, scr, gw, NGW, lane, 1408);
        conv_w(wd + lf * DFF * DM, DM, DFF, DM, MapPlain{d, DFF}, scr, gw, NGW, lane, 768);
    }
}

__device__ __forceinline__ void fold_pq(const float* w_in  , bf16_t* Wab, LAS float* tab  , int gw, int NGW, int lane) {
    for (int it = gw; it < 2048; it += NGW) {
        const int kb = it & 127, mh = (it >> 7) & 1, part = (it >> 8) & 1, g = it >> 9;
        const int m = mh * 64 + lane, k0 = kb * 8;
        float acc[8];
#pragma unroll
        for (int i = 0; i < 8; ++i) acc[i] = 0.f;
        const float* wp = w_in + (size_t)k0 * 2048 + g * 128;
#pragma unroll 8
        for (int c = 0; c < 128; ++c) {
            const float tv = tab[part * 128 + ((m * c) & 127)];
#pragma unroll
            for (int i = 0; i < 8; ++i) acc[i] += wp[(size_t)i * 2048 + c] * tv;
        }
        const float sc = 0.08838834764831845f;
        bf16_t* dst = Wab + (size_t)(part * 512 + g * 128 + m) * 1024 + k0;
        u32x4 w0;
        w0.x = pk2(acc[0] * sc, acc[1] * sc); w0.y = pk2(acc[2] * sc, acc[3] * sc); w0.z = pk2(acc[4] * sc, acc[5] * sc); w0.w = pk2(acc[6] * sc, acc[7] * sc);
        *(u32x4*)dst = w0;
    }
}
__device__ __forceinline__ void gen_dft(bf16_t* D, int N, int logN, float s, int nrows, float sgn, long gtid, long NT) {
    const long nchunk = (long)nrows * 2 * N / 8;
    for (long ch = gtid; ch < nchunk; ch += NT) {
        const long e0 = ch * 8; const int k = (int)(e0 >> (logN + 1)), kk0 = (int)(e0 & (2 * N - 1));
        const bool sn = kk0 >= N; const int n0 = sn ? kk0 - N : kk0;
        float v[8];
#pragma unroll
        for (int i = 0; i < 8; ++i) { const int idx = (k * (n0 + i)) & (N - 1); const float a = (float)idx * (2.0f / (float)N);
            v[i] = sn ? sgn * sinpif(a) * s : cospif(a) * s; }
        u32x4 w; w.x = pk2(v[0], v[1]); w.y = pk2(v[2], v[3]); w.z = pk2(v[4], v[5]); w.w = pk2(v[6], v[7]);
        *(u32x4*)(D + e0) = w;
    }
}
__device__ __forceinline__ void dft_combine(const float* EF, bf16_t* CAT, long gtid, long NT) {
#pragma unroll 4
    for (long it = gtid; it < 2048L * 1024; it += NT) {
        const int k = (int)(it >> 10), c = (int)(it & 1023) * 4, b = c >> 9, j = c & 511;
        const f32x4 e = *(const f32x4*)(EF + (size_t)k * 4096 + c), f = *(const f32x4*)(EF + ((size_t)2048 + k) * 4096 + c);
        const f32x4 d = e - f, a = e + f;
        u32x2 w; w.x = pk2(d[0], d[1]); w.y = pk2(d[2], d[3]);
        *(u32x2*)(CAT + (size_t)(b * TPB + k) * 1024 + j) = w;
        if (k) { u32x2 w2; w2.x = pk2(a[0], a[1]); w2.y = pk2(a[2], a[3]); *(u32x2*)(CAT + (size_t)(b * TPB + 4096 - k) * 1024 + j) = w2; }
    }
}
__device__ __forceinline__ void dft_nyquist(const bf16_t* PQl, bf16_t* CAT, int gw, int NGW, int lane) {
    for (int it = gw; it < 4096; it += NGW) {
        const bf16_t* p = PQl + (size_t)it * 2 * 4096;
        float s = 0.f;
#pragma unroll
        for (int i = 0; i < 8; ++i) { const u32x4 v = *(const u32x4*)(p + (lane + 64 * i) * 8);
#pragma unroll
            for (int q = 0; q < 4; ++q) { const unsigned w = v[q]; s += __builtin_bit_cast(float, w << 16) - __builtin_bit_cast(float, w & 0xffff0000u); } }
        s = wave_sum(s);
        if (lane == 0) CAT[(size_t)((it >> 9) * TPB + 2048) * 1024 + (it & 511)] = (bf16_t)f2bf(s * (1.0f / 64.0f));
    }
}
__device__ __forceinline__ void mod_gemv(const float* c, const float* cctx, const float* ada_w, const float* ada_b, float* mod, LAS float* lds, int tid, int bx, int G) {
    LAS float* s = lds; LAS float* part = lds + 9 * 1024;
    for (int i = tid; i < 9 * 1024; i += 512) { const float v = (i < 8 * 1024) ? c[i] : cctx[i - 8 * 1024]; s[i] = silu_f(v); }
    __syncthreads();
    const int wave = tid >> 6, lane = tid & 63;
    for (int unit = bx; unit < 2 * 128; unit += G) {
        const int layer = unit >> 7, ch = unit & 127;
        const float* W0 = ada_w + (size_t)layer * DM * 9216 + ch * 72 + lane;
        const float* W1 = ada_w + (size_t)layer * DM * 9216 + ch * 72 + 64 + (lane & 7);
        float a0[9], a1[9];
#pragma unroll
        for (int m = 0; m < 9; ++m) { a0[m] = 0.f; a1[m] = 0.f; }
#pragma unroll 16
        for (int kk = 0; kk < 128; ++kk) { const int k = wave * 128 + kk; const float w0 = W0[(size_t)k * 9216], w1 = W1[(size_t)k * 9216];
#pragma unroll
            for (int m = 0; m < 9; ++m) { const float sv = s[m * 1024 + k]; a0[m] += sv * w0; a1[m] += sv * w1; } }
#pragma unroll
        for (int m = 0; m < 9; ++m) { part[(wave * 9 + m) * 72 + lane] = a0[m]; if (lane < 8) part[(wave * 9 + m) * 72 + 64 + lane] = a1[m]; }
        __syncthreads();
        for (int o = tid; o < 9 * 72; o += 512) { const int m = o / 72, l = o - m * 72; float a = 0.f;
#pragma unroll
            for (int w = 0; w < 8; ++w) a += part[(w * 9 + m) * 72 + l];
            mod[((size_t)layer * 9 + m) * 9216 + ch * 72 + l] = a + ada_b[(size_t)layer * 9216 + ch * 72 + l]; }
        __syncthreads();
    }
}

__device__ __forceinline__ int crow(int r, int hi) { return (r & 3) + 8 * (r >> 2) + 4 * hi; }
struct NaFragK { bf16x8 k0[4], k1[4]; };
struct NaFragV { bf16x8 v[8]; };
__device__ __forceinline__ void na_load_k(NaFragK& f, const bf16_t* Kb, int krow0, int h, int r32, int hi) {
#pragma unroll
    for (int d0 = 0; d0 < 4; ++d0) {
        f.k0[d0] = *(const bf16x8*)(Kb + (size_t)(krow0 + r32) * 512 + h * 64 + d0 * 16 + hi * 8);
        f.k1[d0] = *(const bf16x8*)(Kb + (size_t)(krow0 + 32 + r32) * 512 + h * 64 + d0 * 16 + hi * 8);
    }
}
__device__ __forceinline__ void na_load_v(NaFragV& f, const bf16_t* Vb, int krow0, int h, int lane) {
#pragma unroll
    for (int j = 0; j < 8; ++j) f.v[j] = *(const bf16x8*)(Vb + (size_t)(krow0 + (lane >> 3) + 8 * j) * 512 + h * 64 + (lane & 7) * 8);
}
__device__ __forceinline__ int nav_st(int k, int c) { const int kk = (k & ~0xC) | ((k & 4) << 1) | ((k & 8) >> 1); return ((kk >> 3) * 2 + (c >> 5)) * 512 + ((kk & 7) * 32 + (c & 31)) * 2; }
__device__ __forceinline__ int nav_rd_base(int lane) { return ((lane & 3) << 3) | (((lane >> 2) & 3) << 6) | (((lane >> 4) & 1) << 5) | (((lane >> 5) & 1) << 8); }
constexpr int nav_rd_off(int db, int ks, int half) { return db * 512 + ks * 2048 + half * 1024; }
typedef short s16x4_na __attribute__((ext_vector_type(4)));
template <int OFF> __device__ __forceinline__ s16x4_na nav_tr(int vb) { s16x4_na r; asm volatile("ds_read_b64_tr_b16 %0, %1 offset:%2" : "=&v"(r) : "v"(vb), "i"(OFF) : "memory"); return r; }
template <int DB, int KS> __device__ __forceinline__ bf16x8 nav_frag(int vb) {
    const s16x4_na l = nav_tr<nav_rd_off(DB, KS, 0)>(vb), hh = nav_tr<nav_rd_off(DB, KS, 1)>(vb);
    return (bf16x8){l[0], l[1], l[2], l[3], hh[0], hh[1], hh[2], hh[3]};
}
template <bool WIN>
__device__ __forceinline__ void na_compute(const NaFragK& f, const NaFragV& fv, const bf16x8 (&qr)[4], f32x16 (&o)[2], float& mrun, float& lrun, const LAS float* rpb_h,
                                           bool win, int t, int r0, int r, int qc, int cs, int hi, LAS char* vlds, int lane) {
    const float C = 0.125f * LOG2E;
    f32x16 p0, p1;
#pragma unroll
    for (int i = 0; i < 16; ++i) { p0[i] = 0.f; p1[i] = 0.f; }
#pragma unroll
    for (int d0 = 0; d0 < 4; ++d0) {
        p0 = __builtin_amdgcn_mfma_f32_32x32x16_bf16(f.k0[d0], qr[d0], p0, 0, 0, 0);
        p1 = __builtin_amdgcn_mfma_f32_32x32x16_bf16(f.k1[d0], qr[d0], p1, 0, 0, 0);
    }
    if (win) {
        const int ro = r0 + t - r + 7;
        const LAS float* bp = rpb_h + ro * 128 + 48;
        int qc_ = 15 - qc + 4 * hi, cs_ = cs - 4 * hi; asm volatile("" : "+v"(qc_), "+v"(cs_));
#pragma unroll
        for (int i = 0; i < 16; ++i) {
            const int kq = (i & 3) + 8 * (i >> 2);
            const float b0 = bp[kq + qc_], b1 = bp[kq + 32 + qc_];
            p0[i] = ((unsigned)(kq - cs_) < 16u) ? fmaf(p0[i], C, b0) : -INFINITY;
            p1[i] = ((unsigned)(kq + 32 - cs_) < 16u) ? fmaf(p1[i], C, b1) : -INFINITY;
        }
    } else {
#pragma unroll
        for (int i = 0; i < 16; ++i) { p0[i] *= C; p1[i] *= C; }
    }
    float pm = p0[0];
#pragma unroll
    for (int i = 1; i < 16; ++i) pm = fmaxf(pm, p0[i]);
#pragma unroll
    for (int i = 0; i < 16; ++i) pm = fmaxf(pm, p1[i]);
    pm = fmaxf(pm, __shfl_xor(pm, 32));
    const float mn = fmaxf(mrun, pm), alpha = __builtin_amdgcn_exp2f(mrun - mn);
    mrun = mn;
    float ps = 0.f;
#pragma unroll
    for (int i = 0; i < 16; ++i) { p0[i] = __builtin_amdgcn_exp2f(p0[i] - mn); p1[i] = __builtin_amdgcn_exp2f(p1[i] - mn); ps += p0[i] + p1[i]; }
    ps += __shfl_xor(ps, 32);
    lrun = lrun * alpha + ps;
#pragma unroll
    for (int i = 0; i < 16; ++i) { o[0][i] *= alpha; o[1][i] *= alpha; }
#pragma unroll
    for (int j = 0; j < 8; ++j) *(LAS bf16x8*)(vlds + nav_st((lane >> 3) + 8 * j, (lane & 7) * 8)) = fv.v[j];
    bf16x8 pbf[4];
#define NA_PK4(P, BASE, OUT) do { unsigned a0 = pk2(P[BASE + 0], P[BASE + 1]), a1 = pk2(P[BASE + 2], P[BASE + 3]);   \
    unsigned b0 = pk2(P[BASE + 4], P[BASE + 5]), b1 = pk2(P[BASE + 6], P[BASE + 7]);                              \
    auto r0_ = __builtin_amdgcn_permlane32_swap(a0, b0, false, false); auto r1_ = __builtin_amdgcn_permlane32_swap(a1, b1, false, false); \
    u32x4 w_ = {r0_[0], r1_[0], r0_[1], r1_[1]}; OUT = __builtin_bit_cast(bf16x8, w_); } while (0)
    NA_PK4(p0, 0, pbf[0]); NA_PK4(p0, 8, pbf[1]); NA_PK4(p1, 0, pbf[2]); NA_PK4(p1, 8, pbf[3]);
#undef NA_PK4
    const int vb = (int)(unsigned)(uintptr_t)vlds + nav_rd_base(lane);
    const bf16x8 a00 = nav_frag<0, 0>(vb), a10 = nav_frag<1, 0>(vb), a01 = nav_frag<0, 1>(vb), a11 = nav_frag<1, 1>(vb);
    const bf16x8 a02 = nav_frag<0, 2>(vb), a12 = nav_frag<1, 2>(vb), a03 = nav_frag<0, 3>(vb), a13 = nav_frag<1, 3>(vb);
    asm volatile("s_waitcnt lgkmcnt(0)" ::: "memory"); __builtin_amdgcn_sched_barrier(0);
    o[0] = __builtin_amdgcn_mfma_f32_32x32x16_bf16(a00, pbf[0], o[0], 0, 0, 0); o[1] = __builtin_amdgcn_mfma_f32_32x32x16_bf16(a10, pbf[0], o[1], 0, 0, 0);
    o[0] = __builtin_amdgcn_mfma_f32_32x32x16_bf16(a01, pbf[1], o[0], 0, 0, 0); o[1] = __builtin_amdgcn_mfma_f32_32x32x16_bf16(a11, pbf[1], o[1], 0, 0, 0);
    o[0] = __builtin_amdgcn_mfma_f32_32x32x16_bf16(a02, pbf[2], o[0], 0, 0, 0); o[1] = __builtin_amdgcn_mfma_f32_32x32x16_bf16(a12, pbf[2], o[1], 0, 0, 0);
    o[0] = __builtin_amdgcn_mfma_f32_32x32x16_bf16(a03, pbf[3], o[0], 0, 0, 0); o[1] = __builtin_amdgcn_mfma_f32_32x32x16_bf16(a13, pbf[3], o[1], 0, 0, 0);
}
template <bool WIN>
__device__ __forceinline__ void na_unit(const bf16_t* Q, const bf16_t* Kb, const bf16_t* Vb, bf16_t* CAT, const LAS float* rpb_h, int b, int h, int qrow0, int r, int qc0, int lane, LAS char* vlds) {
    const int r32 = lane & 31, hi = lane >> 5;
    bf16x8 qr[4];
#pragma unroll
    for (int d0 = 0; d0 < 4; ++d0) qr[d0] = *(const bf16x8*)(Q + (size_t)(qrow0 + r32) * 512 + h * 64 + d0 * 16 + hi * 8);
    float mrun = -1e30f, lrun = 0.f; f32x16 o[2];
#pragma unroll
    for (int i = 0; i < 16; ++i) { o[0][i] = 0.f; o[1][i] = 0.f; }
    int r0 = r - 4; r0 = r0 < 0 ? 0 : (r0 > 56 ? 56 : r0);
    const int qc = qc0 + r32; int cs = qc - 8; cs = cs < 0 ? 0 : (cs > 48 ? 48 : cs);
    int ua = 0, nwin = 0;
    if (WIN) { ua = r0; nwin = 8; }
    const int nst = nwin + 4;
#define NA_KROW(s) (b * TPB + ((s) < nwin ? (ua + (s)) * 64 : SEQ + ((s) - nwin) * 64))
#define NA_STEP(FK, FV, s) do { const int s_ = (s); const bool win_ = s_ < nwin; const int t_ = ua + s_ - r0; \
        if (!win_ || (t_ >= 0 && t_ < 8)) na_compute<WIN>(FK, FV, qr, o, mrun, lrun, rpb_h, win_, t_, r0, r, qc, cs, hi, vlds, lane); } while (0)
    NaFragK ka, kb; NaFragV fv;
    na_load_k(ka, Kb, NA_KROW(0), h, r32, hi);
    int s = 0;
#pragma unroll 1
    for (; s + 1 < nst; s += 2) {

        na_load_v(fv, Vb, NA_KROW(s), h, lane);
        na_load_k(kb, Kb, NA_KROW(s + 1), h, r32, hi);
        __builtin_amdgcn_sched_barrier(0);
        NA_STEP(ka, fv, s);
        __builtin_amdgcn_sched_barrier(0);

        na_load_v(fv, Vb, NA_KROW(s + 1), h, lane);
        if (s + 2 < nst) na_load_k(ka, Kb, NA_KROW(s + 2), h, r32, hi);
        __builtin_amdgcn_sched_barrier(0);
        NA_STEP(kb, fv, s + 1);
        __builtin_amdgcn_sched_barrier(0);
    }
    if (s < nst) {  na_load_v(fv, Vb, NA_KROW(s), h, lane); NA_STEP(ka, fv, s); }
#undef NA_KROW
#undef NA_STEP
    const float inv = 1.0f / lrun;
    bf16_t* orow = CAT + (size_t)(qrow0 + r32) * 1024 + 512 + h * 64;
#pragma unroll
    for (int db = 0; db < 2; ++db)
#pragma unroll
        for (int r4 = 0; r4 < 4; ++r4) {
            u32x2 w; w.x = pk2(o[db][4 * r4 + 0] * inv, o[db][4 * r4 + 1] * inv); w.y = pk2(o[db][4 * r4 + 2] * inv, o[db][4 * r4 + 3] * inv);
            *(u32x2*)(orow + db * 32 + 8 * r4 + 4 * hi) = w;
        }
}


namespace mla {
using s16x4 = __attribute__((ext_vector_type(4))) short;
constexpr int NW = 8, QBLK = 32, KVBLK = 64;
constexpr float SCALE = 0.07216878364870322f;
constexpr float THR = 8.f;
#ifndef MLA_SDEPTH
#define MLA_SDEPTH 1
#endif
constexpr int SDEPTH = MLA_SDEPTH;
constexpr int LDQ = 1536, LDKN = 1024, LDKR = 64, LDV = 1024, LDO = 1536;
constexpr int KROWB = 400;
constexpr int SHM_V = KVBLK * 128 * 2, SHM_K = KVBLK * KROWB, SHM_ATTN = 2 * SHM_V + 2 * SHM_K + NW * 64 * 4;
#define KSWZ(row, colB) ((row) * KROWB + (colB))
#define SBAR() __builtin_amdgcn_sched_barrier(0)
__device__ __forceinline__ unsigned cvtpk(float lo, float hi) { unsigned r; asm volatile("v_cvt_pk_bf16_f32 %0, %1, %2" : "=v"(r) : "v"(lo), "v"(hi)); return r; }
__device__ __forceinline__ void partialSM(f32x16& p0, f32x16& p1, float& m_reg, float& mn, float& alpha) {
  constexpr float C = SCALE * 1.4426950408889634f;
  float pmax = p0[0];
#pragma unroll
  for (int r = 1; r < 16; ++r) pmax = fmaxf(pmax, p0[r]);
#pragma unroll
  for (int r = 0; r < 16; ++r) pmax = fmaxf(pmax, p1[r]);
  { auto rr = __builtin_amdgcn_permlane32_swap(__float_as_uint(pmax), __float_as_uint(pmax), false, false);
    pmax = fmaxf(__uint_as_float(rr[0]), __uint_as_float(rr[1])); }
  if (__builtin_expect(__all(pmax - m_reg <= THR / SCALE), 1)) { mn = m_reg; alpha = 1.f; }
  else { mn = fmaxf(m_reg, pmax); alpha = __builtin_amdgcn_exp2f((m_reg - mn) * C); m_reg = mn; }
  float mnC = -mn * C;
#pragma unroll
  for (int r = 0; r < 16; ++r) p0[r] = fmaf(p0[r], C, mnC);
#pragma unroll
  for (int r = 0; r < 16; ++r) p1[r] = fmaf(p1[r], C, mnC);
#pragma unroll
  for (int r = 0; r < 16; ++r) p0[r] = __builtin_amdgcn_exp2f(p0[r]);
}
__device__ __forceinline__ void finishSM(f32x16& p0, f32x16& p1, float alpha, float& l_reg, bf16x8& pa0, bf16x8& pa1, bf16x8& pa2, bf16x8& pa3) {
#pragma unroll
  for (int r = 0; r < 16; ++r) p1[r] = __builtin_amdgcn_exp2f(p1[r]);
  float ps = 0;
#pragma unroll
  for (int r = 0; r < 16; ++r) ps += p0[r];
#pragma unroll
  for (int r = 0; r < 16; ++r) ps += p1[r];
  { auto rr = __builtin_amdgcn_permlane32_swap(__float_as_uint(ps), __float_as_uint(ps), false, false);
    ps = __uint_as_float(rr[0]) + __uint_as_float(rr[1]); }
  l_reg = l_reg * alpha + ps;
#define PK4(P, BASE, OUT) do { unsigned a0 = cvtpk(P[BASE + 0], P[BASE + 1]), a1 = cvtpk(P[BASE + 2], P[BASE + 3]);   \
    unsigned b0 = cvtpk(P[BASE + 4], P[BASE + 5]), b1 = cvtpk(P[BASE + 6], P[BASE + 7]);                              \
    auto r0 = __builtin_amdgcn_permlane32_swap(a0, b0, false, false); auto r1 = __builtin_amdgcn_permlane32_swap(a1, b1, false, false); \
    u32x4 w = {r0[0], r1[0], r0[1], r1[1]}; OUT = *reinterpret_cast<bf16x8*>(&w); } while (0)
  PK4(p0, 0, pa0); PK4(p0, 8, pa1); PK4(p1, 0, pa2); PK4(p1, 8, pa3);
#undef PK4
}
#ifndef MLA_QROPE_LDS
#define MLA_QROPE_LDS 1
#endif
constexpr int NQR = MLA_QROPE_LDS ? 8 : 12;
__device__ __forceinline__ void qkt(f32x16& p0, f32x16& p1, const char* Ks, const bf16x8* qr, const char* qrope, int r32, int hi) {
#pragma unroll
  for (int r = 0; r < 16; ++r) { p0[r] = 0.f; p1[r] = 0.f; }
  const char* kb = Ks + r32 * KROWB + hi * 16;
#pragma unroll
  for (int d0 = 0; d0 < 12; ++d0) {
    bf16x8 b0 = *reinterpret_cast<const bf16x8*>(kb + d0 * 32);
    bf16x8 b1 = *reinterpret_cast<const bf16x8*>(kb + d0 * 32 + 32 * KROWB);
    bf16x8 qv;
    if (d0 < NQR) qv = qr[d0 < NQR ? d0 : 0]; else qv = *reinterpret_cast<const bf16x8*>(qrope + (d0 - 8) * 1024);
    p0 = __builtin_amdgcn_mfma_f32_32x32x16_bf16(b0, qv, p0, 0, 0, 0);
    p1 = __builtin_amdgcn_mfma_f32_32x32x16_bf16(b1, qv, p1, 0, 0, 0); }
}
__device__ __forceinline__ int v_st(int k, int c) { const int kk = (k & ~0xC) | ((k & 4) << 1) | ((k & 8) >> 1); return ((kk >> 3) * 4 + (c >> 5)) * 512 + ((kk & 7) * 32 + (c & 31)) * 2; }
__device__ __forceinline__ int v_rd_base(int lane) { return ((lane & 3) << 3) | (((lane >> 2) & 3) << 6) | (((lane >> 4) & 1) << 5) | (((lane >> 5) & 1) << 8); }
constexpr int v_rd_off(int d0, int ks, int half) { return d0 * 512 + ks * 4096 + half * 2048; }
template <int OFF> __device__ __forceinline__ s16x4 tr_read(int vb) {
  s16x4 r; asm volatile("ds_read_b64_tr_b16 %0, %1 offset:%2" : "=&v"(r) : "v"(vb), "i"(OFF) : "memory"); return r;
}
template <int D0> __device__ __forceinline__ void pv_one(f32x16& od, int vb, bf16x8 pa0, bf16x8 pa1, bf16x8 pa2, bf16x8 pa3) {
  const s16x4 l0 = tr_read<v_rd_off(D0, 0, 0)>(vb), h0 = tr_read<v_rd_off(D0, 0, 1)>(vb), l1 = tr_read<v_rd_off(D0, 1, 0)>(vb), h1 = tr_read<v_rd_off(D0, 1, 1)>(vb);
  const s16x4 l2 = tr_read<v_rd_off(D0, 2, 0)>(vb), h2 = tr_read<v_rd_off(D0, 2, 1)>(vb), l3 = tr_read<v_rd_off(D0, 3, 0)>(vb), h3 = tr_read<v_rd_off(D0, 3, 1)>(vb);
  asm volatile("s_waitcnt lgkmcnt(0)" ::: "memory"); SBAR();
#define PK(L, H) (bf16x8){L[0], L[1], L[2], L[3], H[0], H[1], H[2], H[3]}
  od = __builtin_amdgcn_mfma_f32_32x32x16_bf16(pa0, PK(l0, h0), od, 0, 0, 0);
  od = __builtin_amdgcn_mfma_f32_32x32x16_bf16(pa1, PK(l1, h1), od, 0, 0, 0);
  od = __builtin_amdgcn_mfma_f32_32x32x16_bf16(pa2, PK(l2, h2), od, 0, 0, 0);
  od = __builtin_amdgcn_mfma_f32_32x32x16_bf16(pa3, PK(l3, h3), od, 0, 0, 0);
#undef PK
}
__device__ __forceinline__ void pv_d0(f32x16* o, int vb, bf16x8 pa0, bf16x8 pa1, bf16x8 pa2, bf16x8 pa3) {
  pv_one<0>(o[0], vb, pa0, pa1, pa2, pa3); pv_one<1>(o[1], vb, pa0, pa1, pa2, pa3); pv_one<2>(o[2], vb, pa0, pa1, pa2, pa3); pv_one<3>(o[3], vb, pa0, pa1, pa2, pa3);
}
__device__ __forceinline__ void attn_body(const bf16_t* Qb, const bf16_t* __restrict__ KNh, const bf16_t* __restrict__ KRb, const bf16_t* __restrict__ Vh, bf16_t* Ob, int seq, char* lds) {
  const int tid = threadIdx.x, wid = tid >> 6, lane = tid & 63, r32 = lane & 31, hi = lane >> 5;
  char* V_lds = lds; char* K_lds = lds + 2 * SHM_V;
  float* ws = (float*)(lds + 2 * SHM_V + 2 * SHM_K) + wid * 64; float* li_l = ws; float* al_l = ws + 32;
  float m_reg = -1e30f, l_reg = 0; f32x16 o[4]; bf16x8 qr[NQR];
#pragma unroll
  for (int d = 0; d < 4; ++d)
#pragma unroll
    for (int r = 0; r < 16; ++r) o[d][r] = 0.f;
  const bf16_t* Qw = Qb + (long)(wid * QBLK + r32) * LDQ + hi * 8;
  char* qrope = lds + 2 * SHM_V + 2 * SHM_K + NW * 64 * 4 + wid * 4096 + hi * 512 + r32 * 16;
#pragma unroll
  for (int d0 = 0; d0 < 12; ++d0) { const bf16x8 qv = *reinterpret_cast<const bf16x8*>(Qw + d0 * 16);
    if (d0 < NQR) qr[d0 < NQR ? d0 : 0] = qv; else *reinterpret_cast<bf16x8*>(qrope + (d0 - 8) * 1024) = qv; }
  const int sr = tid >> 4, sc = (tid & 15) * 8, vst0 = v_st(sr, sc), vst1 = v_st(32 + sr, sc);
  const int rr_ = tid >> 3, rc = (tid & 7) * 8;
  const int vb0 = (int)(uintptr_t)V_lds + v_rd_base(lane);
  struct { bf16x8 vs0, vs1, ks0, ks1, kr0; } sr_[SDEPTH];
#define SLOAD(i, k0) do { sr_[i].vs0 = *(const bf16x8*)(&Vh[(long)((k0) + sr) * LDV + sc]); sr_[i].vs1 = *(const bf16x8*)(&Vh[(long)((k0) + 32 + sr) * LDV + sc]); \
    sr_[i].ks0 = *(const bf16x8*)(&KNh[(long)((k0) + sr) * LDKN + sc]); sr_[i].ks1 = *(const bf16x8*)(&KNh[(long)((k0) + 32 + sr) * LDKN + sc]); \
    sr_[i].kr0 = *(const bf16x8*)(&KRb[(long)((k0) + rr_) * LDKR + rc]); } while (0)
#define SWRITE(b, i) do { *(bf16x8*)(V_lds + (b) * SHM_V + vst0) = sr_[i].vs0;          \
    *(bf16x8*)(V_lds + (b) * SHM_V + vst1) = sr_[i].vs1; const int kc = sc * 2;               \
    *(bf16x8*)(K_lds + (b) * SHM_K + KSWZ(sr, kc)) = sr_[i].ks0;                       \
    *(bf16x8*)(K_lds + (b) * SHM_K + KSWZ(32 + sr, kc)) = sr_[i].ks1;                  \
    *(bf16x8*)(K_lds + (b) * SHM_K + KSWZ(rr_, 256 + rc * 2)) = sr_[i].kr0; } while (0)
#define SWAIT() do { if constexpr (SDEPTH == 2) asm volatile("s_waitcnt vmcnt(5)" ::: "memory"); else asm volatile("s_waitcnt vmcnt(0)" ::: "memory"); } while (0)
#define RESC(a) do { if (__any((a) < 1.f)) { if (hi == 0) al_l[r32] = (a); asm volatile("s_waitcnt lgkmcnt(0)" ::: "memory"); \
    _Pragma("unroll") for (int d = 0; d < 4; ++d) _Pragma("unroll") for (int r = 0; r < 16; ++r) o[d][r] *= al_l[crow(r, hi)]; } } while (0)
  f32x16 pA0, pA1, pB0, pB1; float mnA, mnB, alA, alB; bf16x8 pa0, pa1, pa2, pa3; const int NT = seq / KVBLK;
  constexpr int SE = 0, SO = SDEPTH - 1;
  SLOAD(SE, 0); asm volatile("s_waitcnt vmcnt(0)" ::: "memory"); SWRITE(0, SE); __syncthreads();
  qkt(pA0, pA1, K_lds, qr, qrope, r32, hi); partialSM(pA0, pA1, m_reg, mnA, alA);
  SLOAD(SO, KVBLK); if constexpr (SDEPTH == 2) { if (2 < NT) SLOAD(SE, 2 * KVBLK); }
  SWAIT(); SWRITE(1, SO); __syncthreads();
  for (int j = 1; j + 1 < NT; j += 2) {
    SBAR(); qkt(pB0, pB1, K_lds + SHM_K, qr, qrope, r32, hi);
    finishSM(pA0, pA1, alA, l_reg, pa0, pa1, pa2, pa3); SBAR();
    SLOAD(SO, (j + SDEPTH) * KVBLK); SBAR();
    pv_d0(o, vb0, pa0, pa1, pa2, pa3); partialSM(pB0, pB1, m_reg, mnB, alB);
    __syncthreads(); SWAIT(); SWRITE(0, SE);
    RESC(alB); __syncthreads();
    SBAR(); qkt(pA0, pA1, K_lds, qr, qrope, r32, hi);
    finishSM(pB0, pB1, alB, l_reg, pa0, pa1, pa2, pa3); SBAR();
    if (SDEPTH == 1 || j + 3 < NT) SLOAD(SE, (j + 1 + SDEPTH) * KVBLK); SBAR();
    pv_d0(o, vb0 + (int)SHM_V, pa0, pa1, pa2, pa3); partialSM(pA0, pA1, m_reg, mnA, alA);
    __syncthreads(); SWAIT(); SWRITE(1, SO);
    RESC(alA); __syncthreads();
  }
  SBAR(); qkt(pB0, pB1, K_lds + SHM_K, qr, qrope, r32, hi);
  finishSM(pA0, pA1, alA, l_reg, pa0, pa1, pa2, pa3); SBAR();
  pv_d0(o, vb0, pa0, pa1, pa2, pa3); partialSM(pB0, pB1, m_reg, mnB, alB);
  __syncthreads(); RESC(alB);
  finishSM(pB0, pB1, alB, l_reg, pa0, pa1, pa2, pa3); SBAR();
  pv_d0(o, vb0 + (int)SHM_V, pa0, pa1, pa2, pa3);
  if (hi == 0) li_l[r32] = l_reg; asm volatile("s_waitcnt lgkmcnt(0)" ::: "memory");
  float rli[16];
#pragma unroll
  for (int r = 0; r < 16; ++r) rli[r] = __builtin_amdgcn_rcpf(li_l[crow(r, hi)]);
  bf16_t* Ow = Ob + (long)(wid * QBLK) * LDO;
#pragma unroll
  for (int r = 0; r < 16; ++r) { const int orow = crow(r, hi);
#pragma unroll
    for (int d0 = 0; d0 < 4; ++d0) Ow[(long)orow * LDO + d0 * 32 + r32] = (bf16_t)f2bf(o[d0][r] * rli[r]); }
  __syncthreads();
#undef SLOAD
#undef SWRITE
#undef SWAIT
#undef RESC
}
#undef KSWZ
#undef SBAR
}


typedef unsigned v4u_xb __attribute__((ext_vector_type(4)));
#define XB_TMO      128
#define XB_XCNT(j)  (256  + 64 * (j))
#define XB_XSUB(j)  (1280 + 64 * (j))
#define XB_XGEN(j)  (2304 + 64 * (j))
#define XB_TOP      3328
#define XB_TOPGEN   3392
#define XCD_BAR_WORDS 3456
#define XB_SPIN_CAP (1u << 18)

__device__ __forceinline__ unsigned xb_ld(unsigned* p)              { return __hip_atomic_load(p, __ATOMIC_RELAXED, __HIP_MEMORY_SCOPE_AGENT); }
__device__ __forceinline__ unsigned xb_add(unsigned* p, unsigned v) { return __hip_atomic_fetch_add(p, v, __ATOMIC_RELAXED, __HIP_MEMORY_SCOPE_AGENT); }
__device__ __forceinline__ unsigned xb_xcc_id() { return (unsigned)__builtin_amdgcn_s_getreg((3 << 11) | 20) & 0xFu; }
#define XB_SPIN(cond, bar) do { unsigned _sp = 0; while (cond) { __builtin_amdgcn_s_sleep(1); \
    if ((++_sp & 255u) == 0u) { if (xb_ld(&(bar)[XB_TMO])) break; if (_sp > XB_SPIN_CAP) { atomicAdd(&(bar)[XB_TMO], 1u); break; } } } } while (0)

struct XcdBarrier {
    unsigned* bar; unsigned x;
    volatile LAS unsigned* st;
};

__device__ __forceinline__ XcdBarrier xcd_barrier_post(unsigned* bar, volatile LAS unsigned* st) {
    XcdBarrier b; b.bar = bar; b.x = xb_xcc_id(); b.st = st;
    if (threadIdx.x == 0) (void)xb_add(&bar[XB_XCNT(b.x)], 1u);
    return b;
}
__device__ __forceinline__ void xcd_barrier_complete(unsigned* bar, unsigned x, unsigned& nloc, unsigned& nx) {
    const unsigned G = gridDim.x * gridDim.y * gridDim.z;
    unsigned sum, cnt, mine, sp = 0u;
    for (;;) {
        sum = 0u; cnt = 0u; mine = 0u;
#pragma unroll
        for (unsigned j = 0; j < 16; ++j) { const unsigned c = xb_ld(&bar[XB_XCNT(j)]); sum += c; cnt += (c > 0u) ? 1u : 0u; mine = (j == x) ? c : mine; }
        if (sum == G) break;
        __builtin_amdgcn_s_sleep(1);
        if ((++sp & 255u) == 0u) { if (xb_ld(&bar[XB_TMO])) break; if (sp > XB_SPIN_CAP) { atomicAdd(&bar[XB_TMO], 1u); break; } }
    }
    nloc = mine > 0u ? mine : 1u; nx = cnt > 0u ? cnt : 1u;
}

__device__ __forceinline__ void xcd_barrier(const XcdBarrier& b) {
    asm volatile("s_waitcnt vmcnt(0)" ::: "memory");
    __syncthreads();
    if (threadIdx.x == 0) {
        unsigned* bar = b.bar;
        __builtin_amdgcn_s_waitcnt(0);
        unsigned nloc = b.st[0], nx = b.st[1];
        if (nloc == 0u) { xcd_barrier_complete(bar, b.x, nloc, nx); b.st[0] = nloc; b.st[1] = nx; }
        const unsigned old = xb_add(&bar[XB_XSUB(b.x)], 1u);
        const unsigned gen = old / nloc;
        if (old + 1u == (gen + 1u) * nloc) {
            __builtin_amdgcn_fence(__ATOMIC_RELEASE, "agent");
            asm volatile("s_waitcnt vmcnt(0)" ::: "memory");
            const unsigned og = xb_add(&bar[XB_TOP], 1u);
            const unsigned tg = og / nx;
            if (og + 1u == (tg + 1u) * nx) xb_add(&bar[XB_TOPGEN], 1u);
            else XB_SPIN(xb_ld(&bar[XB_TOPGEN]) == tg, bar);
            __builtin_amdgcn_fence(__ATOMIC_ACQUIRE, "agent");
            xb_add(&bar[XB_XGEN(b.x)], 1u);
            asm volatile("s_waitcnt vmcnt(0)" ::: "memory");
        } else {
            XB_SPIN(xb_ld(&bar[XB_XGEN(b.x)]) == gen, bar);
            __builtin_amdgcn_fence(__ATOMIC_ACQUIRE, "agent");
            asm volatile("s_waitcnt vmcnt(0)" ::: "memory");
        }
    }
    __syncthreads();
}

__device__ __forceinline__ void grid_bar(unsigned* ctr, unsigned target) {
    asm volatile("s_waitcnt vmcnt(0)" ::: "memory");
    __syncthreads();
    if (threadIdx.x == 0) {
        __builtin_amdgcn_fence(__ATOMIC_RELEASE, "agent");
        asm volatile("s_waitcnt vmcnt(0)" ::: "memory");
        __hip_atomic_fetch_add(ctr, 1u, __ATOMIC_RELAXED, __HIP_MEMORY_SCOPE_AGENT);
        while (__hip_atomic_load(ctr, __ATOMIC_RELAXED, __HIP_MEMORY_SCOPE_AGENT) < target) __builtin_amdgcn_s_sleep(2);
        __builtin_amdgcn_fence(__ATOMIC_ACQUIRE, "agent");
        asm volatile("s_waitcnt vmcnt(0)" ::: "memory");
    }
    __syncthreads();
}
__device__ __forceinline__ int fresh_lane() { int t = threadIdx.x; asm volatile("" : "+v"(t)); return t & 63; }
struct Args { const float* in[21]; float* out; unsigned char* ws; int ph_lo, ph_hi; };
constexpr int NPHASE = 24;

__global__ void __launch_bounds__(NWAVES * 64, 2) fwd_kernel(Args args) {
    extern __shared__ __attribute__((aligned(16))) unsigned char lds_raw[];
    cg::grid_group grid = cg::this_grid();
    LAS unsigned char* lds = (LAS unsigned char*)lds_raw;
    const int tid = threadIdx.x, wave = __builtin_amdgcn_readfirstlane(tid >> 6);
#define lane fresh_lane()
    const int G = gridDim.x, bx = blockIdx.x;
    const int vcu = (G % 8 == 0) ? (bx % 8) * (G / 8) + bx / 8 : bx;
    const int gw = vcu * NWAVES + wave, NGW = G * NWAVES;
    unsigned char* ws = args.ws;
    float* cosT = (float*)(ws + WS_ROPE); float* sinT = cosT + 1024;
    float* mod = (float*)(ws + WS_MOD); const float* mod0 = mod; const float* mod1 = mod + (size_t)9 * 9216;
    float* X = (float*)(ws + WS_X);
    bf16_t* H = (bf16_t*)(ws + WS_H);
    bf16_t* ACT = (bf16_t*)(ws + WS_A);
    const int lo = args.ph_lo, hi = args.ph_hi;
    volatile LAS unsigned* xb_st = (volatile LAS unsigned*)(lds + 131072 + 64);
    if (tid < 2) xb_st[tid] = 0u;
    __syncthreads();
    if (hi - lo > 1) (void)xcd_barrier_post((unsigned*)(ws + 8192), xb_st);
    if (hi - lo > 1) grid.sync();
#define IN(k) (lo <= (k) && (k) < hi)
#define SEAM(k) do { if (IN(k) && IN((k) + 1)) { XcdBarrier xb_; xb_.bar = (unsigned*)(ws + 8192); xb_.x = xb_xcc_id(); xb_.st = (volatile LAS unsigned*)(lds + 131072 + 64); xcd_barrier(xb_); } } while (0)
#define GEMM(EpiT, SchedT, g, S, E) pg8::gemm_phase<EpiT, SchedT, true, true>(lds, g, S, E)
#define GEMM_SEQ(EpiT, SchedT, g, S, E) pg8::gemm_phase<EpiT, SchedT, false, true>(lds, g, S, E)

    if (IN(0)) {
        for (int i = gw * 64 + lane; i < 1024; i += NGW * 64) { const int pos = i >> 4, j = i & 15; const float inv = powf(10000.0f, -(float)(2 * j) / 32.0f); const float a = (float)pos * inv;
            cosT[i] = cosf(a); sinT[i] = sinf(a); }
        mod_gemv(args.in[1], args.in[3], args.in[4], args.in[5], mod, (LAS float*)lds, tid, bx, G);
        __syncthreads();
        LAS float* scr = (LAS float*)(lds + wave * 16384);
        conv_ffn(args.in[7], args.in[8], args.in[9], 0, ws, W0_WGU0, W0_WD0, W0_WGU1, W0_WD1, scr, gw, NGW, lane);
        conv_w(args.in[10] + 512, 2048, 1024, 1536, MapPlain{(bf16_t*)(ws + W0_WAB) + (size_t)1024 * 1024, 1024}, scr, gw, NGW, lane, 300);
        conv_w(args.in[12], 1024, 1024, 1024, MapPlain{(bf16_t*)(ws + W0_WOUT), 1024}, scr, gw, NGW, lane, 1100);
        __syncthreads();
        { LAS float* tab = (LAS float*)lds;
          if (tid < 256) { const int i = tid & 127; const float a = (float)i * (2.0f / 128.0f); tab[tid] = (tid < 128) ? cospif(a) : sinpif(a); }
          __syncthreads();
          fold_pq(args.in[10], (bf16_t*)(ws + W0_WAB), tab, gw, NGW, lane);
          __syncthreads(); }
        gen_dft((bf16_t*)(ws + WS_DFTL), 4096, 12, 1.0f / 64.0f, 2048, 1.0f, (long)gw * 64 + lane, (long)NGW * 64);
        gen_dft((bf16_t*)(ws + WS_DFTC), 256, 8, 1.0f / 16.0f, 256, -1.0f, (long)gw * 64 + lane, (long)NGW * 64);
    }
    SEAM(0);
    if (IN(1)) norm_pass(nullptr, args.in[0], args.in[2], args.in[6] + 0 * DM, mod0, 0, 1, H, false, gw, NGW, lane, X);
    SEAM(1);
    if (IN(2)) { pg8::Gemm g{H, (const bf16_t*)(ws + W0_WGU0), MTOT, 2 * DFF, DM}; pg8::StaticOrder S; S.init(MTOT, 2 * DFF, G, bx); EpiSwiGLU E{ACT}; GEMM(EpiSwiGLU, pg8::StaticOrder, g, S, E); }
    SEAM(2);
    if (IN(3)) { pg8::Gemm g{ACT, (const bf16_t*)(ws + W0_WD0), MTOT, DM, DFF}; { pg8::StaticOrder S; S.init(TAIL_ROW0, DM, G, bx); EpiResidIn E{args.in[0], args.in[2], X, mod0, 2, 0.5f}; GEMM_SEQ(EpiResidIn, pg8::StaticOrder, g, S, E); } { TailOrder<4> S; S.init(DFF, G, bx); EpiPartial E{args.out, mod0, 2, 0.5f}; GEMM(EpiPartial, TailOrder<4>, g, S, E); } }
    SEAM(3);
    if (IN(4)) norm_pass(X, args.in[0], args.in[2], args.in[6] + 1 * DM, mod0, 3, 4, H, false, gw, NGW, lane, X, args.out, 4);
    SEAM(4);
    if (IN(5)) {
        const bf16_t* Wab = (const bf16_t*)(ws + W0_WAB);
        { pg8::Gemm g{Wab, H, 1024, MTOT, DM}; pg8::StaticOrder S; S.init(1024, MTOT, G, bx); EpiPQT E{(bf16_t*)(ws + A_PQL), (bf16_t*)(ws + A_PQC)}; GEMM(EpiPQT, pg8::StaticOrder, g, S, E); }
        { pg8::Gemm g{H, Wab + (size_t)1024 * 1024, MTOT, 1536, DM}; RotOrder S; S.init(MTOT, 1536, G, bx, 224);
          pg8::EpiBf16<0> E{(bf16_t*)(ws + A_QN), 512, nullptr, 512, (A_KNA - A_QN) / 2, 1.0f}; GEMM(pg8::EpiBf16<0>, RotOrder, g, S, E); }
    }
    SEAM(5);
    if (IN(6)) {
        { pg8::Gemm g{(const bf16_t*)(ws + WS_DFTL), (const bf16_t*)(ws + A_PQL), 2048, 4096, 8192}; DftPieceOrder S; S.init(G, bx); EpiEF E{args.out}; GEMM(EpiEF, DftPieceOrder, g, S, E); }
        { pg8::Gemm g{(const bf16_t*)(ws + WS_DFTC), (const bf16_t*)(ws + A_PQC), 256, 4096, 512}; RotOrder S; S.init(256, 4096, G, bx, 128); EpiDFT E{H, SEQ}; GEMM(EpiDFT, RotOrder, g, S, E); }
        __syncthreads();
        LAS float* rpb = (LAS float*)(lds + 65536);
        for (int i = tid; i < 8 * 15 * 128; i += 512) { const int j = (i & 127) - 48; rpb[i] = (j >= 0 && j < 31) ? args.in[11][(i >> 7) * 31 + j] * LOG2E : 0.f; }
        __syncthreads();
        const bf16_t* QN = (const bf16_t*)(ws + A_QN); const bf16_t* KNA = (const bf16_t*)(ws + A_KNA); const bf16_t* VT = (const bf16_t*)(ws + A_VT);
        for (int u0 = vcu * 8; u0 < 8192; u0 += G * 8) {
            const int u = u0 + wave, qh = u & 1, r = (u >> 1) & 63, h = (u >> 7) & 7, b = u >> 10;
            na_unit<true>(QN, KNA, VT, H, rpb + h * 1920, b, h, b * TPB + r * 64 + qh * 32, r, qh * 32, lane, (LAS char*)(lds + wave * 8192));
        }
        for (int u0 = bx * 8; u0 < 512; u0 += G * 8) {
            const int u = u0 + wave, qb = u & 7, h = (u >> 3) & 7, b = u >> 6;
            na_unit<false>(QN, KNA, VT, H, rpb, b, h, b * TPB + SEQ + qb * 32, 0, 0, lane, (LAS char*)(lds + wave * 8192));
        }
        __syncthreads();
        if (hi - lo > 1) { XcdBarrier xb_; xb_.bar = (unsigned*)(ws + 8192); xb_.x = xb_xcc_id(); xb_.st = (volatile LAS unsigned*)(lds + 131072 + 64); xcd_barrier(xb_); }
        dft_combine(args.out, H, (long)gw * 64 + lane, (long)NGW * 64);
        dft_nyquist((const bf16_t*)(ws + A_PQL), H, gw, NGW, lane);
    }
    SEAM(6);
    if (IN(7)) { pg8::Gemm g{H, (const bf16_t*)(ws + W0_WOUT), MTOT, DM, DM}; { pg8::StaticOrder S; S.init(TAIL_ROW0, DM, G, bx); EpiResid E{X, mod0, 5, 1.0f}; GEMM_SEQ(EpiResid, pg8::StaticOrder, g, S, E); } { TailOrder<4> S; S.init(DM, G, bx); EpiPartial E{args.out, mod0, 5, 1.0f}; GEMM(EpiPartial, TailOrder<4>, g, S, E); } }
    SEAM(7);
    if (IN(8)) {
        norm_pass(X, args.in[0], args.in[2], args.in[6] + 2 * DM, mod0, 6, 7, H, false, gw, NGW, lane, X, args.out, 4);
        LAS float* scr = (LAS float*)(lds + wave * 16384);
        conv_ffn(args.in[7], args.in[8], args.in[9], 1, ws, W1_WGU0, W1_WD0, W1_WGU1, W1_WD1, scr, gw, NGW, lane);
        conv_w(args.in[13], 576, 1024, 576, MapPlain{(bf16_t*)(ws + W1_WIN), 1024}, scr, gw, NGW, lane, 100);
        conv_w(args.in[16], 1536, 384, 1536, MapPlain{(bf16_t*)(ws + W1_WUQ), 384}, scr, gw, NGW, lane, 500);
        conv_w(args.in[17], 1024, 128, 1024, MapPlain{(bf16_t*)(ws + W1_WUKV), 256}, scr, gw, NGW, lane, 900);
        conv_w(args.in[18], 1024, 128, 1024, MapPlain{(bf16_t*)(ws + W1_WUKV) + (size_t)1024 * 256, 256}, scr, gw, NGW, lane, 1000);
        conv_w(args.in[19], 1024, 1024, 1024, MapWo{(bf16_t*)(ws + W1_WO)}, scr, gw, NGW, lane, 1200);
        const long gt = (long)gw * 64 + lane, NT_ = (long)NGW * 64; const u32x4 z4 = {0u, 0u, 0u, 0u};
        for (long i = gt; i < 192 * 128; i += NT_) *(u32x4*)((bf16_t*)(ws + W1_WIN) + (size_t)576 * 1024 + i * 8) = z4;
        for (long i = gt; i < 2048 * 16; i += NT_) *(u32x4*)((bf16_t*)(ws + W1_WUKV) + (i >> 4) * 256 + 128 + (i & 15) * 8) = z4;
        for (long i = gt; i < 1024 * 64; i += NT_) *(u32x4*)((bf16_t*)(ws + W1_WO) + (i >> 6) * 1536 + ((i >> 3) & 7) * 192 + 128 + (i & 7) * 8) = z4;
    }
    SEAM(8);
    if (IN(9)) { pg8::Gemm g{H, (const bf16_t*)(ws + W0_WGU1), MTOT, 2 * DFF, DM}; pg8::StaticOrder S; S.init(MTOT, 2 * DFF, G, bx); EpiSwiGLU E{ACT}; GEMM(EpiSwiGLU, pg8::StaticOrder, g, S, E); }
    SEAM(9);
    if (IN(10)) { pg8::Gemm g{ACT, (const bf16_t*)(ws + W0_WD1), MTOT, DM, DFF}; { pg8::StaticOrder S; S.init(TAIL_ROW0, DM, G, bx); EpiResid E{X, mod0, 8, 0.5f}; GEMM_SEQ(EpiResid, pg8::StaticOrder, g, S, E); } { TailOrder<4> S; S.init(DFF, G, bx); EpiPartial E{args.out, mod0, 8, 0.5f}; GEMM(EpiPartial, TailOrder<4>, g, S, E); } }
    SEAM(10);
    if (IN(11)) norm_pass(X, args.in[0], args.in[2], args.in[6] + 3 * DM, mod1, 0, 1, H, false, gw, NGW, lane, X, args.out, 4);
    SEAM(11);
    if (IN(12)) { pg8::Gemm g{H, (const bf16_t*)(ws + W1_WGU0), MTOT, 2 * DFF, DM}; pg8::StaticOrder S; S.init(MTOT, 2 * DFF, G, bx); EpiSwiGLU E{ACT}; GEMM(EpiSwiGLU, pg8::StaticOrder, g, S, E); }
    SEAM(12);
    if (IN(13)) { pg8::Gemm g{ACT, (const bf16_t*)(ws + W1_WD0), MTOT, DM, DFF}; { pg8::StaticOrder S; S.init(TAIL_ROW0, DM, G, bx); EpiResid E{X, mod1, 2, 0.5f}; GEMM_SEQ(EpiResid, pg8::StaticOrder, g, S, E); } { TailOrder<4> S; S.init(DFF, G, bx); EpiPartial E{args.out, mod1, 2, 0.5f}; GEMM(EpiPartial, TailOrder<4>, g, S, E); } }
    SEAM(13);
    if (IN(14)) norm_pass(X, args.in[0], args.in[2], args.in[6] + 4 * DM, mod1, 3, 4, H, false, gw, NGW, lane, X, args.out, 4);
    SEAM(14);
    if (IN(15)) { pg8::Gemm g{H, (const bf16_t*)(ws + W1_WIN), MTOT, 768, DM}; pg8::StaticOrder S; S.init(MTOT, 768, G, bx); EpiZ E{(float*)(ws + A_Z)}; GEMM(EpiZ, pg8::StaticOrder, g, S, E); }
    SEAM(15);
    if (IN(16)) mla_norm_pass((const float*)(ws + A_Z), args.in[14], args.in[15], cosT, sinT, (bf16_t*)(ws + A_CQ), (bf16_t*)(ws + A_CKV), (bf16_t*)(ws + A_KR), gw, NGW, lane);
    SEAM(16);
    if (IN(17)) {
        { int k384 = 384; asm volatile("" : "+s"(k384)); pg8::Gemm g{(const bf16_t*)(ws + A_CQ), (const bf16_t*)(ws + W1_WUQ), MTOT, 1536, k384}; LatentOrder S; S.init(1536, G, bx); EpiQRope E{(bf16_t*)(ws + A_QB), cosT, sinT}; GEMM(EpiQRope, LatentOrder, g, S, E); }
        { int k256 = 256; asm volatile("" : "+s"(k256)); pg8::Gemm g{(const bf16_t*)(ws + A_CKV), (const bf16_t*)(ws + W1_WUKV), MTOT, 2048, k256}; pg8::StaticOrder S; S.init(MTOT, 2048, G, bx);
          pg8::EpiBf16<0> E{H, 1024, nullptr, 1024, (size_t)((ws + WS_VB) - (ws + WS_H)) / 2, 1.0f}; GEMM(pg8::EpiBf16<0>, pg8::StaticOrder, g, S, E); }
    }
    SEAM(17);
    if (IN(18)) {
        bf16_t* QB = (bf16_t*)(ws + A_QB); const bf16_t* KN = H; const bf16_t* KR = (const bf16_t*)(ws + A_KR); const bf16_t* VB = (const bf16_t*)(ws + WS_VB);
        const int per = (1024 + G - 1) / G;
        for (int i = 0; i < per; ++i) {
            const int u = vcu * per + i; if (u >= 1024) break;
            const int qb = u & 15, h = (u >> 4) & 7, b = u >> 7;
            const size_t qrow = (size_t)b * TPB + qb * 256, krow = (size_t)b * TPB;
            mla::attn_body(QB + qrow * 1536 + h * 192, KN + krow * 1024 + h * 128, KR + krow * 64, VB + krow * 1024 + h * 128, QB + qrow * 1536 + h * 192, TPB, (char*)lds_raw);
        }
    }
    SEAM(18);
    if (IN(19)) { pg8::Gemm g{(const bf16_t*)(ws + A_QB), (const bf16_t*)(ws + W1_WO), MTOT, DM, 1536}; LatentOrder S; S.init(DM, G, bx); EpiResid E{X, mod1, 5, 1.0f}; GEMM_SEQ(EpiResid, LatentOrder, g, S, E); }
    SEAM(19);
    if (IN(20)) norm_pass(X, args.in[0], args.in[2], args.in[6] + 5 * DM, mod1, 6, 7, H, true, gw, NGW, lane);
    SEAM(20);
    if (IN(21)) { pg8::Gemm g{H, (const bf16_t*)(ws + W1_WGU1), MTOT, 2 * DFF, DM}; LatentOrder S; S.init(2 * DFF, G, bx); EpiSwiGLU E{ACT}; GEMM(EpiSwiGLU, LatentOrder, g, S, E); }
    SEAM(21);
    if (IN(22)) { pg8::Gemm g{ACT, (const bf16_t*)(ws + W1_WD1), MTOT, DM, DFF}; LatentOrder S; S.init(DM, G, bx); EpiResid E{X, mod1, 8, 0.5f}; GEMM_SEQ(EpiResid, LatentOrder, g, S, E); }
    SEAM(22);
    if (IN(23)) final_norm(X, args.in[20], args.out, gw, NGW, lane);
#undef IN
#undef SEAM
#undef GEMM
#undef GEMM_SEQ
#undef lane
}

#ifndef N_LAUNCH_MODE
#define N_LAUNCH_MODE 1
#endif
extern "C" void kernel_launch(void* const* d_in, const int* in_sizes, int n_in, void* d_out, int out_size, void* d_ws, size_t ws_size, hipStream_t stream) {
    static int grid = 0;
    if (grid == 0) {
        if (n_in != 21 || ws_size < WS_END) { fprintf(stderr, "kernel_launch: n_in %d ws %zu (need %zu)\n", n_in, ws_size, (size_t)WS_END); grid = -1; return; }
        int dev = 0, cus = 0, per_cu = 0;
        hipGetDevice(&dev);
        hipDeviceGetAttribute(&cus, hipDeviceAttributeMultiprocessorCount, dev);
        hipFuncSetAttribute((const void*)fwd_kernel, hipFuncAttributeMaxDynamicSharedMemorySize, LDS_BYTES);
        hipOccupancyMaxActiveBlocksPerMultiprocessor(&per_cu, (const void*)fwd_kernel, NWAVES * 64, LDS_BYTES);
        if (per_cu < 1) per_cu = 1;
        (void)hipGetLastError();
        grid = cus * per_cu;
    }
    if (grid < 0) return;
    Args a{};
    for (int i = 0; i < 21; ++i) a.in[i] = (const float*)d_in[i];
    a.out = (float*)d_out; a.ws = (unsigned char*)d_ws;
    (void)hipMemsetAsync(d_ws, 0, 32768, stream);
#if N_LAUNCH_MODE == 1
    a.ph_lo = 0; a.ph_hi = NPHASE;
    void* kargs[] = {&a};
    hipError_t e = hipLaunchCooperativeKernel((const void*)fwd_kernel, dim3(grid), dim3(NWAVES * 64), kargs, LDS_BYTES, stream);
    if (e != hipSuccess) fprintf(stderr, "cooperative launch failed: %s (grid %d)\n", hipGetErrorString(e), grid);
#else
    for (int p = 0; p < NPHASE; ++p) { a.ph_lo = p; a.ph_hi = p + 1; hipLaunchKernelGGL(fwd_kernel, dim3(grid), dim3(NWAVES * 64), LDS_BYTES, stream, a); }
#endif
}
```
